# Optimizing an MI355X kernel written in HIP

```python
import jax, jax.numpy as jnp
from jax import lax
import numpy as np

D_MODEL = 1024
BATCH = 8
SEQ = 2048
DEPTH = 4

GRID_W = 64
CTX_LEN = 256
D_FF = 2816
N_MOD = 9
EPS = 1e-6
ROPE_THETA = 10000.0
BLOCK_Q = 128

GQA_HEADS = 6
GQA_KV_HEADS = 2
GQA_HEAD_DIM = 64
GQA_Q = GQA_HEADS * GQA_HEAD_DIM
GQA_KV = GQA_KV_HEADS * GQA_HEAD_DIM
GQA_IN = GQA_Q + 2 * GQA_KV
CONV_DIM = 256
CONV_GROUPS = 4
CONV_WIDTH = 3
CONV_IN = 3 * CONV_DIM
MLA_HEADS = 6
MLA_Q_LORA = 384
MLA_KV_LORA = 256
MLA_NOPE = 64
MLA_ROPE = 32
MLA_V = 64
MLA_IN = MLA_Q_LORA + MLA_KV_LORA + MLA_ROPE

D_MIX = GQA_Q + CONV_DIM + MLA_HEADS * MLA_V
IN_COLS = GQA_IN + CONV_IN + MLA_IN

kernel_name = "hybrid_gqa_conv_mla_macaron_dit"


def rms_norm(x, g):
    xf = x.astype(jnp.float32)
    y = xf * lax.rsqrt(jnp.mean(xf * xf, axis=-1, keepdims=True) + EPS)
    return (y * g.astype(jnp.float32)).astype(x.dtype)


def modulate(h, shift, scale):
    return h * (1 + scale) + shift


def swiglu(h, wg, wu, wd):
    return (jax.nn.silu(h @ wg) * (h @ wu)) @ wd


def half_ffn(h, g, shift, scale, gate, wg, wu, wd):
    return h + 0.5 * gate * swiglu(modulate(rms_norm(h, g), shift, scale), wg, wu, wd)


def rope_tables(row, col, dim):
    half = dim // 2
    inv = 1.0 / (ROPE_THETA ** (jnp.arange(0, half, 2, dtype=jnp.float32) / half))
    ar = row[:, None] * inv[None, :]
    ac = col[:, None] * inv[None, :]
    ang = jnp.concatenate([ar, ar, ac, ac], axis=-1)
    return jnp.cos(ang), jnp.sin(ang)


def apply_rope(x, cos, sin):
    x0, x1, x2, x3 = jnp.split(x, 4, axis=-1)
    rot = jnp.concatenate([-x1, x0, -x3, x2], axis=-1)
    return (x * cos + rot * sin).astype(x.dtype)


def block_attention(q, k, v):
    b, hk, g, sq, dk = q.shape
    nb = sq // BLOCK_Q
    scale = dk ** -0.5
    qb = jnp.moveaxis(q.reshape(b, hk, g, nb, BLOCK_Q, dk), 3, 0)

    def one_block(qi):
        s = jnp.einsum('bhgqd,bhkd->bhgqk', qi, k).astype(jnp.float32) * scale
        p = jax.nn.softmax(s, axis=-1).astype(v.dtype)
        return jnp.einsum('bhgqk,bhkd->bhgqd', p, v)

    o = lax.map(one_block, qb)
    return jnp.moveaxis(o, 0, 3).reshape(b, hk, g, sq, v.shape[-1])


def merge_heads(o):
    b, hk, g, s, d = o.shape
    return o.transpose(0, 3, 1, 2, 4).reshape(b, s, hk * g * d)


def gqa_heads(p, g_q, g_k):
    b, s, _ = p.shape
    q, k, v = jnp.split(p, [GQA_Q, GQA_Q + GQA_KV], axis=-1)
    q = q.reshape(b, s, GQA_KV_HEADS, GQA_HEADS // GQA_KV_HEADS, GQA_HEAD_DIM).transpose(0, 2, 3, 1, 4)
    k = k.reshape(b, s, GQA_KV_HEADS, GQA_HEAD_DIM).transpose(0, 2, 1, 3)
    v = v.reshape(b, s, GQA_KV_HEADS, GQA_HEAD_DIM).transpose(0, 2, 1, 3)
    return rms_norm(q, g_q), rms_norm(k, g_k), v


def gqa_mix(p_lat, p_ctx, g_q, g_k, cos, sin, need_ctx):
    q_l, k_l, v_l = gqa_heads(p_lat, g_q, g_k)
    q_c, k_c, v_c = gqa_heads(p_ctx, g_q, g_k)
    q_l = apply_rope(q_l, cos, sin)
    k_l = apply_rope(k_l, cos, sin)
    o_l = block_attention(q_l, jnp.concatenate([k_c, k_l], axis=2), jnp.concatenate([v_c, v_l], axis=2))
    o_c = merge_heads(block_attention(q_c, k_c, v_c)) if need_ctx else None
    return merge_heads(o_l), o_c


def short_conv(p, w, bias):
    x_in, b_gate, c_gate = jnp.split(p, 3, axis=-1)
    u = c_gate * x_in
    s = u.shape[1]
    pad = CONV_WIDTH // 2
    up = jnp.pad(u, ((0, 0), (pad, pad), (0, 0)))
    y = sum(up[:, j:j + s] * w[j] for j in range(CONV_WIDTH)) + bias
    return b_gate * y


def mla_heads(p, g_cq, g_ckv, w_uq, w_ukv, g_qn, g_kn, g_qr, g_kr):
    b, s, _ = p.shape
    cq, ckv, kr = jnp.split(p, [MLA_Q_LORA, MLA_Q_LORA + MLA_KV_LORA], axis=-1)
    q = (rms_norm(cq, g_cq) @ w_uq).reshape(b, s, MLA_HEADS, MLA_NOPE + MLA_ROPE).transpose(0, 2, 1, 3)
    kv = (rms_norm(ckv, g_ckv) @ w_ukv).reshape(b, s, MLA_HEADS, MLA_NOPE + MLA_V).transpose(0, 2, 1, 3)
    q_nope, q_rope = jnp.split(q, [MLA_NOPE], axis=-1)
    k_nope, v = jnp.split(kv, [MLA_NOPE], axis=-1)
    q_nope = rms_norm(q_nope, g_qn)
    q_rope = rms_norm(q_rope, g_qr)
    k_nope = rms_norm(k_nope, g_kn)
    k_rope = rms_norm(kr, g_kr)[:, None]
    return q_nope, q_rope, k_nope, k_rope, v


def mla_assemble(q_nope, q_rope, k_nope, k_rope):
    q = jnp.concatenate([q_nope, q_rope], axis=-1)[:, :, None]
    k = jnp.concatenate([k_nope, jnp.broadcast_to(k_rope, k_nope.shape[:-1] + (MLA_ROPE,))], axis=-1)
    return q, k


def mla_mix(p_lat, p_ctx, g_cq, g_ckv, w_uq, w_ukv, g_qn, g_kn, g_qr, g_kr, cos, sin, need_ctx):
    qn_l, qr_l, kn_l, kr_l, v_l = mla_heads(p_lat, g_cq, g_ckv, w_uq, w_ukv, g_qn, g_kn, g_qr, g_kr)
    qn_c, qr_c, kn_c, kr_c, v_c = mla_heads(p_ctx, g_cq, g_ckv, w_uq, w_ukv, g_qn, g_kn, g_qr, g_kr)
    q_l, k_l = mla_assemble(qn_l, apply_rope(qr_l, cos, sin), kn_l, apply_rope(kr_l, cos, sin))
    q_c, k_c = mla_assemble(qn_c, qr_c, kn_c, kr_c)
    o_l = block_attention(q_l, jnp.concatenate([k_c, k_l], axis=2), jnp.concatenate([v_c, v_l], axis=2))
    o_c = merge_heads(block_attention(q_c, k_c, v_c)) if need_ctx else None
    return merge_heads(o_l), o_c


def token_mixing(h_lat, h_ctx, w_in, w_out, gqa_g_q, gqa_g_k, conv_w, conv_b,
                 mla_g_cq, mla_g_ckv, mla_w_uq, mla_w_ukv, mla_g_qn, mla_g_kn, mla_g_qr, mla_g_kr,
                 cos_a, sin_a, cos_m, sin_m, need_ctx):
    splits = [GQA_IN, GQA_IN + CONV_IN]
    a_l, s_l, m_l = jnp.split(h_lat @ w_in, splits, axis=-1)
    a_c, s_c, m_c = jnp.split(h_ctx @ w_in, splits, axis=-1)
    ya_l, ya_c = gqa_mix(a_l, a_c, gqa_g_q, gqa_g_k, cos_a, sin_a, need_ctx)
    ym_l, ym_c = mla_mix(m_l, m_c, mla_g_cq, mla_g_ckv, mla_w_uq, mla_w_ukv,
                         mla_g_qn, mla_g_kn, mla_g_qr, mla_g_kr, cos_m, sin_m, need_ctx)
    y_l = jnp.concatenate([ya_l, short_conv(s_l, conv_w, conv_b), ym_l], axis=-1) @ w_out
    y_c = None
    if need_ctx:
        y_c = jnp.concatenate([ya_c, short_conv(s_c, conv_w, conv_b), ym_c], axis=-1) @ w_out
    return y_l, y_c


def setup_inputs(seed: int = 0) -> dict:
    key = jax.random.key(seed)
    ks = list(jax.random.split(key, 32))
    it = iter(ks)
    d = D_MODEL

    def nrm(shape, std):
        return std * jax.random.normal(next(it), shape, jnp.float32)

    return {
        "x": nrm((BATCH, SEQ, d), 1.0),
        "c": nrm((BATCH, d), 1.0),
        "ctx": nrm((BATCH, CTX_LEN, d), 1.0),
        "c_ctx": nrm((d,), 1.0),
        "w_mod": nrm((DEPTH, d, N_MOD * d), 0.5 * d ** -0.5),
        "b_mod": nrm((DEPTH, N_MOD * d), 0.02),
        "g_norm": 1.0 + nrm((DEPTH, 3, d), 0.02),
        "ffn_w_gate": nrm((DEPTH, 2, d, D_FF), d ** -0.5),
        "ffn_w_up": nrm((DEPTH, 2, d, D_FF), d ** -0.5),
        "ffn_w_down": nrm((DEPTH, 2, D_FF, d), D_FF ** -0.5),
        "w_in": nrm((DEPTH, d, IN_COLS), d ** -0.5),
        "w_out": nrm((DEPTH, D_MIX, d), D_MIX ** -0.5),
        "gqa_g_q": 1.0 + nrm((DEPTH, GQA_HEAD_DIM), 0.02),
        "gqa_g_k": 1.0 + nrm((DEPTH, GQA_HEAD_DIM), 0.02),
        "conv_w": nrm((DEPTH, CONV_WIDTH, CONV_DIM), CONV_WIDTH ** -0.5),
        "conv_b": nrm((DEPTH, CONV_DIM), 0.02),
        "mla_g_cq": 1.0 + nrm((DEPTH, MLA_Q_LORA), 0.02),
        "mla_g_ckv": 1.0 + nrm((DEPTH, MLA_KV_LORA), 0.02),
        "mla_w_uq": nrm((DEPTH, MLA_Q_LORA, MLA_HEADS * (MLA_NOPE + MLA_ROPE)), MLA_Q_LORA ** -0.5),
        "mla_w_ukv": nrm((DEPTH, MLA_KV_LORA, MLA_HEADS * (MLA_NOPE + MLA_V)), MLA_KV_LORA ** -0.5),
        "mla_g_qn": 1.0 + nrm((DEPTH, MLA_NOPE), 0.02),
        "mla_g_kn": 1.0 + nrm((DEPTH, MLA_NOPE), 0.02),
        "mla_g_qr": 1.0 + nrm((DEPTH, MLA_ROPE), 0.02),
        "mla_g_kr": 1.0 + nrm((DEPTH, MLA_ROPE), 0.02),
    }


def reference(x, c, ctx, c_ctx, w_mod, b_mod, g_norm, ffn_w_gate, ffn_w_up, ffn_w_down,
              w_in, w_out, gqa_g_q, gqa_g_k, conv_w, conv_b, mla_g_cq, mla_g_ckv,
              mla_w_uq, mla_w_ukv, mla_g_qn, mla_g_kn, mla_g_qr, mla_g_kr):
    n_lat = x.shape[1]
    rows = n_lat // GRID_W
    row = jnp.repeat(jnp.arange(rows, dtype=jnp.float32), GRID_W)
    col = jnp.tile(jnp.arange(GRID_W, dtype=jnp.float32), rows)
    cos_a, sin_a = rope_tables(row, col, GQA_HEAD_DIM)
    cos_m, sin_m = rope_tables(row, col, MLA_ROPE)
    s_lat = jax.nn.silu(c)[:, None, :]
    s_ctx = jax.nn.silu(c_ctx)
    for l in range(DEPTH):
        need_ctx = l < DEPTH - 1
        ml = jnp.split(s_lat @ w_mod[l] + b_mod[l], N_MOD, axis=-1)
        mc = jnp.split(s_ctx @ w_mod[l] + b_mod[l], N_MOD, axis=-1)
        x = half_ffn(x, g_norm[l, 0], ml[0], ml[1], ml[2], ffn_w_gate[l, 0], ffn_w_up[l, 0], ffn_w_down[l, 0])
        ctx = half_ffn(ctx, g_norm[l, 0], mc[0], mc[1], mc[2], ffn_w_gate[l, 0], ffn_w_up[l, 0], ffn_w_down[l, 0])
        h_lat = modulate(rms_norm(x, g_norm[l, 1]), ml[3], ml[4])
        h_ctx = modulate(rms_norm(ctx, g_norm[l, 1]), mc[3], mc[4])
        y_l, y_c = token_mixing(h_lat, h_ctx, w_in[l], w_out[l], gqa_g_q[l], gqa_g_k[l], conv_w[l], conv_b[l],
                                mla_g_cq[l], mla_g_ckv[l], mla_w_uq[l], mla_w_ukv[l],
                                mla_g_qn[l], mla_g_kn[l], mla_g_qr[l], mla_g_kr[l],
                                cos_a, sin_a, cos_m, sin_m, need_ctx)
        x = x + ml[5] * y_l
        x = half_ffn(x, g_norm[l, 2], ml[6], ml[7], ml[8], ffn_w_gate[l, 1], ffn_w_up[l, 1], ffn_w_down[l, 1])
        if need_ctx:
            ctx = ctx + mc[5] * y_c
            ctx = half_ffn(ctx, g_norm[l, 2], mc[6], mc[7], mc[8], ffn_w_gate[l, 1], ffn_w_up[l, 1], ffn_w_down[l, 1])
    return x
```

```cpp
#include <hip/hip_runtime.h>
#include <hip/hip_cooperative_groups.h>
#include <cstdio>
#include <cstdint>
namespace cg = cooperative_groups;
namespace pg8 {
#define PG8_LAS __attribute__((address_space(3)))
typedef unsigned short bf16_t;
typedef short bf16x8 __attribute__((ext_vector_type(8)));
typedef float f32x4 __attribute__((ext_vector_type(4)));
typedef unsigned u32x4 __attribute__((ext_vector_type(4)));
constexpr int BM = 256, BK = 64, HALF = 128, HTB = HALF * BK * 2  , STAGE_BYTES = 8 * HTB, NXCD = 8, WGM = 8;

__host__ __device__ __forceinline__ int lds_byte(int r, int c) { const int st = (r >> 4) * 2 + (c >> 5), rr = r & 15, cc = c & 31, ob = rr * 64 + cc * 2; return st * 1024 + (ob ^ (((ob >> 9) & 1) << 5)); }
__host__ __device__ __forceinline__ void stage_rc(int b, int& R, int& C) { const int st = b / 1024, sb = b % 1024, swz = sb ^ (((sb >> 9) & 1) << 5); R = (st >> 1) * 16 + swz / 64; C = (st & 1) * 32 + (swz % 64) / 2; }
__host__ __device__ __forceinline__ int perm32(int rho) { const int n = rho >> 4, i = rho & 15; return 8 * (i >> 2) + 4 * n + (i & 3); }

struct Unit { int pm, pn, kt0, ntk, part; };
struct Gemm { const bf16_t* A; const bf16_t* Bt; int M, N, K; };

struct StaticOrder {
    int nM, nN, nwg, G, c, ntk;
    __host__ __device__ void init(int M, int N, int G_, int c_, int K_) { nM = M / BM; nN = N / BM; nwg = nM * nN; G = G_; c = c_; ntk = K_ / BK; }
    __host__ __device__ bool next(int i, Unit& u) const {
        const long L = (long)i * G + c; if (L >= nwg) return false;
        int wgid = (int)L; { const int q = nwg / NXCD, r = nwg % NXCD, xcd = wgid % NXCD, off = wgid / NXCD; wgid = (xcd < r ? xcd * (q + 1) : r * (q + 1) + (xcd - r) * q) + off; }
        const int nig = WGM * nN, gid = wgid / nig, fm = gid * WGM, gsz = (nM - fm) < WGM ? (nM - fm) : WGM;
        u.pm = fm + ((wgid % nig) % gsz); u.pn = (wgid % nig) / gsz; u.kt0 = 0; u.ntk = ntk; u.part = 0; return true;
    }
    __device__ __forceinline__ void a_ready(const Unit&) const {}
    __device__ __forceinline__ void done(const Unit&) const {}
};

__device__ __forceinline__ unsigned cvt_pk_bf16(float lo, float hi) { unsigned r; asm volatile("v_cvt_pk_bf16_f32 %0, %1, %2" : "=v"(r) : "v"(lo), "v"(hi)); return r; }
typedef float f32x2 __attribute__((ext_vector_type(2)));
template <int ACT  > struct EpiBf16 {
    static constexpr bool PERM = true, AFTER_DRAIN = false; static_assert(ACT == 0, "EpiBf16: ACT is 0");
    bf16_t* O; int ldc; const float* bias; int split_cols; size_t split_stride; float scale0;
    __device__ __forceinline__ void operator()(const f32x4 (&acc)[2][2][4][2], const Unit& u, int wr, int wc, int fr, int fq) const {
        const int row0 = u.pm * BM + wr * 64 + fr; int colt = u.pn * BM; bf16_t* base = O;
        float sc = 1.f; if (split_cols) { const int t = colt / split_cols; base += (size_t)t * split_stride; colt -= t * split_cols; if (t == 0) sc = scale0; }
        const int col0 = colt + wc * 32 + 8 * fq, bcol0 = u.pn * BM + wc * 32 + 8 * fq;
        f32x4 bv[2][2];
#pragma unroll
        for (int bj = 0; bj < 2; ++bj)
#pragma unroll
            for (int n = 0; n < 2; ++n) bv[bj][n] = bias ? *(const f32x4*)(bias + bcol0 + bj * HALF + 4 * n) : (f32x4){0.f, 0.f, 0.f, 0.f};
#pragma unroll
        for (int ai = 0; ai < 2; ++ai)
#pragma unroll
            for (int m = 0; m < 4; ++m) { bf16_t* rowp = base + (size_t)(row0 + ai * HALF + m * 16) * ldc + col0;
#pragma unroll
                for (int bj = 0; bj < 2; ++bj) { f32x4 v0 = acc[ai][bj][m][0] + bv[bj][0], v1 = acc[ai][bj][m][1] + bv[bj][1];
                    v0 = v0 * sc; v1 = v1 * sc; u32x4 w; w.x = cvt_pk_bf16(v0[0], v0[1]); w.y = cvt_pk_bf16(v0[2], v0[3]); w.z = cvt_pk_bf16(v1[0], v1[1]); w.w = cvt_pk_bf16(v1[2], v1[3]);
                    if (!(ldc == 2304 && col0 + bj * HALF >= 2080)) *(u32x4*)(rowp + bj * HALF) = w; } }
    }
};
template <class Epi, class Sched, bool ALIGN_EPI = false, bool SP2 = false>
__device__ __forceinline__ void gemm_phase(PG8_LAS unsigned char* lds, const Gemm g, const Sched& S, const Epi& E, int tid_) {
    asm volatile("" : "+v"(tid_));
    const int tid = tid_, wid = __builtin_amdgcn_readfirstlane(tid >> 6), lane = tid & 63, wr = wid >> 2, wc = wid & 3, fr = lane & 15, fq = lane >> 4;
    const int K = g.K; int nt;
    unsigned voffA[2], voffB[2];
#pragma unroll
    for (int i = 0; i < 2; ++i) { int R, C; stage_rc(tid * 16 + i * 8192, R, C); const int Rb = Epi::PERM ? ((R & ~31) + perm32(R & 31)) : R;
        voffA[i] = (unsigned)(R * K + C) * 2u; voffB[i] = (unsigned)(Rb * K + C) * 2u; }
    const size_t kstep = (size_t)(BK * 2);
    const size_t hstep = (size_t)HALF * K * 2;
    const size_t tstep = 2 * hstep;
    const unsigned ldsw = (unsigned)wid * 1024u;
    const int aoff = lds_byte(wr * 64 + fr, fq * 8), boff = lds_byte(wc * 32 + fr, fq * 8);
#define PG8_SA(b, h) (((b) * 2 + (h)) * HTB)
#define PG8_SB(b, h) ((4 + (b) * 2 + (h)) * HTB)
#define PG8_STAGE(bufoff, gbase, voff) do { _Pragma("unroll") for (int _i = 0; _i < 2; ++_i) \
        __builtin_amdgcn_global_load_lds((const unsigned*)((const char*)(gbase) + (voff)[_i]), (PG8_LAS unsigned*)(lds + (bufoff) + ldsw + _i * 8192), 16, 0, 0); } while (0)
#define PG8_LDA(dst, b, h) do { _Pragma("unroll") for (int m = 0; m < 4; ++m) _Pragma("unroll") for (int k = 0; k < 2; ++k) dst[m][k] = *(const PG8_LAS bf16x8*)(lds + PG8_SA(b, h) + aoff + m * 2048 + k * 1024); } while (0)
#define PG8_LDB(dst, b, h) do { _Pragma("unroll") for (int n = 0; n < 2; ++n) _Pragma("unroll") for (int k = 0; k < 2; ++k) dst[n][k] = *(const PG8_LAS bf16x8*)(lds + PG8_SB(b, h) + boff + n * 2048 + k * 1024); } while (0)
#define PG8_MMA(ai, bj, At, Bt) do { __builtin_amdgcn_s_setprio(1); _Pragma("unroll") for (int m = 0; m < 4; ++m) _Pragma("unroll") for (int n = 0; n < 2; ++n) _Pragma("unroll") for (int k = 0; k < 2; ++k) \
        acc[ai][bj][m][n] = __builtin_amdgcn_mfma_f32_16x16x32_bf16(Bt[n][k], At[m][k], acc[ai][bj][m][n], 0, 0, 0); __builtin_amdgcn_s_setprio(0); } while (0)
#define PG8_WAIT_V(n) asm volatile("s_waitcnt vmcnt(" #n ")" ::: "memory")
#define PG8_WAIT_L(n) asm volatile("s_waitcnt lgkmcnt(" #n ")" ::: "memory")
#define PG8_BAR __builtin_amdgcn_s_barrier()
#define PG8_SCHED __builtin_amdgcn_sched_barrier(0)
    Unit cur, nxt; int ui = 0;
    if (!S.next(0, cur)) return;
    f32x4 acc[2][2][4][2];
#pragma unroll
    for (int a = 0; a < 2; ++a)
#pragma unroll
        for (int b = 0; b < 2; ++b)
#pragma unroll
            for (int m = 0; m < 4; ++m)
#pragma unroll
                for (int n = 0; n < 2; ++n) acc[a][b][m][n] = (f32x4){0.f, 0.f, 0.f, 0.f};
    bf16x8 At[4][2], B0[2][2], B1[2][2];
    const char* cA = (const char*)g.A + (size_t)cur.pm * tstep + (size_t)cur.kt0 * kstep; const char* cB = (const char*)g.Bt + (size_t)cur.pn * tstep + (size_t)cur.kt0 * kstep; nt = cur.ntk;
    S.a_ready(cur);
    if constexpr (SP2) {
        PG8_STAGE(PG8_SB(0, 0), cB, voffB); PG8_STAGE(PG8_SB(0, 1), cB + hstep, voffB); PG8_STAGE(PG8_SA(0, 0), cA, voffA); PG8_STAGE(PG8_SA(0, 1), cA + hstep, voffA);
        if (wr == 1) PG8_BAR;
        PG8_WAIT_V(2); PG8_BAR;
        PG8_STAGE(PG8_SB(1, 0), cB + kstep, voffB); PG8_STAGE(PG8_SA(1, 0), cA + kstep, voffA); PG8_STAGE(PG8_SB(1, 1), cB + hstep + kstep, voffB);
        PG8_WAIT_V(6); PG8_BAR;
    } else {
        PG8_STAGE(PG8_SB(0, 0), cB, voffB); PG8_STAGE(PG8_SA(0, 0), cA, voffA); PG8_STAGE(PG8_SB(0, 1), cB + hstep, voffB); PG8_STAGE(PG8_SA(0, 1), cA + hstep, voffA);
        if (wr == 1) PG8_BAR;
        PG8_WAIT_V(4); PG8_BAR;
        PG8_STAGE(PG8_SB(1, 0), cB + kstep, voffB); PG8_STAGE(PG8_SA(1, 0), cA + kstep, voffA); PG8_STAGE(PG8_SB(1, 1), cB + hstep + kstep, voffB);
        PG8_WAIT_V(6); PG8_BAR;
    }
    for (;;) {
        const bool has_next = S.next(ui + 1, nxt);
        const char* nA = has_next ? (const char*)g.A + (size_t)nxt.pm * tstep + (size_t)nxt.kt0 * kstep : cA; const char* nB = has_next ? (const char*)g.Bt + (size_t)nxt.pn * tstep + (size_t)nxt.kt0 * kstep : cB;
        for (int t = 0; t < nt; t += 2) {
            const bool last = (t == nt - 2);
            const char* a1 = cA + (size_t)(t + 1) * kstep;
            const char* a2 = last ? nA : cA + (size_t)(t + 2) * kstep; const char* b2 = last ? nB : cB + (size_t)(t + 2) * kstep;
            const char* a3 = a2 + kstep; const char* b3 = b2 + kstep;
            if (last && has_next) S.a_ready(nxt);
            if constexpr (SP2) {
            PG8_LDB(B0, 0, 0); PG8_LDB(B1, 0, 1); PG8_SCHED; PG8_LDA(At, 0, 0); PG8_STAGE(PG8_SA(1, 1), a1 + hstep, voffA);
            PG8_WAIT_V(8); PG8_WAIT_L(0); PG8_BAR; PG8_MMA(0, 0, At, B0); PG8_MMA(0, 1, At, B1); PG8_BAR; PG8_SCHED;
            PG8_LDA(At, 0, 1); PG8_STAGE(PG8_SB(0, 0), b2, voffB); PG8_STAGE(PG8_SB(0, 1), b2 + hstep, voffB); PG8_STAGE(PG8_SA(0, 0), a2, voffA);
            PG8_WAIT_V(8); PG8_WAIT_L(0); PG8_BAR; PG8_MMA(1, 0, At, B0); PG8_MMA(1, 1, At, B1); PG8_BAR; PG8_SCHED;
            PG8_LDB(B0, 1, 0); PG8_LDB(B1, 1, 1); PG8_SCHED; PG8_LDA(At, 1, 0); PG8_STAGE(PG8_SA(0, 1), a2 + hstep, voffA);
            PG8_WAIT_V(8); PG8_WAIT_L(0); PG8_BAR; PG8_MMA(0, 0, At, B0); PG8_MMA(0, 1, At, B1); PG8_BAR; PG8_SCHED;
            PG8_LDA(At, 1, 1); PG8_STAGE(PG8_SB(1, 0), b3, voffB); PG8_STAGE(PG8_SB(1, 1), b3 + hstep, voffB); PG8_STAGE(PG8_SA(1, 0), a3, voffA);
            PG8_WAIT_V(8); PG8_WAIT_L(0); PG8_BAR; PG8_MMA(1, 0, At, B0); PG8_MMA(1, 1, At, B1); PG8_BAR; PG8_SCHED;
            } else {
            PG8_LDB(B0, 0, 0); PG8_SCHED; PG8_LDA(At, 0, 0); PG8_STAGE(PG8_SA(1, 1), a1 + hstep, voffA);
            PG8_WAIT_L(8); PG8_BAR; PG8_WAIT_L(0); PG8_MMA(0, 0, At, B0); PG8_BAR; PG8_SCHED;
            PG8_LDB(B1, 0, 1); PG8_STAGE(PG8_SB(0, 0), b2, voffB);
            PG8_BAR; PG8_WAIT_L(0); PG8_MMA(0, 1, At, B1); PG8_BAR;
            PG8_LDA(At, 0, 1); PG8_STAGE(PG8_SA(0, 0), a2, voffA);
            PG8_BAR; PG8_WAIT_L(0); PG8_MMA(1, 0, At, B0); PG8_BAR; PG8_SCHED;
            PG8_STAGE(PG8_SB(0, 1), b2 + hstep, voffB);
            PG8_WAIT_V(6); PG8_BAR; PG8_MMA(1, 1, At, B1); PG8_BAR;
            PG8_LDB(B0, 1, 0); PG8_SCHED; PG8_LDA(At, 1, 0); PG8_STAGE(PG8_SA(0, 1), a2 + hstep, voffA);
            PG8_WAIT_L(8); PG8_BAR; PG8_WAIT_L(0); PG8_MMA(0, 0, At, B0); PG8_BAR; PG8_SCHED;
            PG8_LDB(B1, 1, 1); PG8_STAGE(PG8_SB(1, 0), b3, voffB);
            PG8_BAR; PG8_WAIT_L(0); PG8_MMA(0, 1, At, B1); PG8_BAR;
            PG8_LDA(At, 1, 1); PG8_STAGE(PG8_SA(1, 0), a3, voffA);
            PG8_BAR; PG8_WAIT_L(0); PG8_MMA(1, 0, At, B0); PG8_BAR; PG8_SCHED;
            PG8_STAGE(PG8_SB(1, 1), b3 + hstep, voffB);
            PG8_WAIT_V(6); PG8_BAR; PG8_MMA(1, 1, At, B1); PG8_BAR;
            }
        }
        if constexpr (ALIGN_EPI) { if (wr == 0) PG8_BAR; }
        if constexpr (!Epi::AFTER_DRAIN) { E(acc, cur, wr, wc, fr, fq); S.done(cur); }
        if (!has_next) break;
#pragma unroll
        for (int a = 0; a < 2; ++a)
#pragma unroll
            for (int b = 0; b < 2; ++b)
#pragma unroll
                for (int m = 0; m < 4; ++m)
#pragma unroll
                    for (int n = 0; n < 2; ++n) acc[a][b][m][n] = (f32x4){0.f, 0.f, 0.f, 0.f};
        cur = nxt; cA = nA; cB = nB; nt = cur.ntk; ++ui;
        if constexpr (ALIGN_EPI) { if (wr == 1) PG8_BAR; }
    }
    PG8_WAIT_V(0);
    if constexpr (!ALIGN_EPI) { if (wr == 0) PG8_BAR; }
    PG8_BAR;
    if constexpr (Epi::AFTER_DRAIN) { E.fused(acc, cur, wr, wc, fr, fq, lds, wid, lane); S.done(cur); }
#undef PG8_SA
#undef PG8_SB
#undef PG8_STAGE
#undef PG8_LDA
#undef PG8_LDB
#undef PG8_MMA
#undef PG8_WAIT_V
#undef PG8_WAIT_L
#undef PG8_BAR
#undef PG8_SCHED
}
}

#ifndef MK_MULTI
#define MK_MULTI 0
#endif
#ifndef DBL
#define DBL 0
#endif
#ifndef EN
#define EN 0xffff
#endif
#define LAS __attribute__((address_space(3)))
#define GAS __attribute__((address_space(1)))
typedef unsigned short bf16;
typedef float f32x4 __attribute__((ext_vector_type(4)));
typedef unsigned u32x4 __attribute__((ext_vector_type(4)));
typedef unsigned u32x2 __attribute__((ext_vector_type(2)));

constexpr int DM = 1024, NB = 8, SEQ = 2048, DEPTH = 4, CTXL = 256, DFF = 2816, NMOD = 9;
constexpr int MLAT = NB * SEQ, MCTX = NB * CTXL, MTOT = MLAT + MCTX;
constexpr int LKV = CTXL + SEQ;
constexpr int INC = 2080, INP = 2304;
constexpr int PC_K = 384, PC_V = 512, PC_X = 640, PC_BG = 896, PC_CG = 1152, PC_CQ = 1408, PC_CKV = 1792, PC_KR = 2048;
constexpr int NGU = 2 * DFF;
constexpr float EPS = 1e-6f;
constexpr float LOG2E = 1.4426950408889634f;
constexpr float QSCALE_A = 0.125f * LOG2E;
constexpr float QSCALE_M = 0.10206207261596577f * LOG2E;
constexpr float L2THETA = 13.287712379549449f;

constexpr size_t MiB = 1u << 20;
constexpr size_t WS_MOD = 0;
constexpr size_t WS_CTL = 1536 * 1024, CTL_BYTES = 16384;
constexpr size_t WS_WGU = 2 * MiB;
constexpr size_t SZ_WGU = (size_t)NGU * DM * 2;
constexpr size_t WS_WD = WS_WGU + 8 * SZ_WGU;
constexpr size_t SZ_WD = (size_t)DM * DFF * 2;
constexpr size_t WS_WIN = WS_WD + 8 * SZ_WD;
constexpr size_t SZ_WIN = (size_t)INP * DM * 2;
constexpr size_t WS_WOUT = WS_WIN + 4 * SZ_WIN;
constexpr size_t SZ_WOUT = (size_t)DM * DM * 2;
constexpr size_t WS_WUP = WS_WOUT + 4 * SZ_WOUT;
constexpr size_t SZ_WUP = (size_t)1536 * 640 * 2;
constexpr size_t WS_X = WS_WUP + 4 * SZ_WUP;
constexpr size_t WS_H = WS_X + (size_t)MTOT * DM * 4;
constexpr size_t WS_R = WS_H + (size_t)MTOT * DM * 2;
constexpr size_t WS_GU = WS_R;
constexpr size_t WS_P = WS_R;
constexpr size_t WS_QKVR = WS_R;
constexpr size_t WS_CQKV = WS_P + (size_t)MTOT * INP * 2;
constexpr size_t WS_QA = WS_CQKV + (size_t)MTOT * 640 * 2;
constexpr size_t WS_PART = WS_QA;
constexpr size_t WS_KA = WS_QA + (size_t)NB * 6 * LKV * 64 * 2;
constexpr size_t WS_VA = WS_KA + (size_t)NB * 2 * LKV * 64 * 2;
constexpr size_t WS_QM = WS_VA + (size_t)NB * 2 * LKV * 64 * 2;
constexpr size_t WS_KM = WS_QM + (size_t)NB * 6 * LKV * 96 * 2;
constexpr size_t WS_VM = WS_KM + (size_t)NB * 6 * LKV * 96 * 2;
constexpr size_t WS_YC = WS_VM + (size_t)NB * 6 * LKV * 64 * 2;
constexpr size_t WS_END = WS_YC + (size_t)MTOT * DM * 2;
static_assert(WS_QKVR + (size_t)MTOT * 1536 * 2 <= WS_CQKV, "QKVR overlays P");
static_assert(WS_GU + (size_t)MTOT * DFF * 2 <= WS_END, "GU inside the shared region");
static_assert(WS_X % 256 == 0 && WS_R % 256 == 0 && WS_QA % 256 == 0 && WS_YC % 256 == 0, "alignment");

#ifndef SPLITS
#define SPLITS 4
#endif
static_assert(WS_PART >= WS_GU + (size_t)MTOT * DFF * 2 && WS_PART + (size_t)SPLITS * MCTX * DM * 4 <= WS_YC, "split-K parts overlay QA..VM (all dead while the parts are live), clear of GU and YC");
constexpr int LDS_BYTES = 147456;
constexpr int NPHASE = 1 + 13 * DEPTH;

__device__ __forceinline__ float shx(float v, int o, int lane) { return __builtin_bit_cast(float, __builtin_amdgcn_ds_bpermute((lane ^ o) << 2, __builtin_bit_cast(int, v))); }
__device__ __forceinline__ float dpp_x1(float v) { return __builtin_bit_cast(float, __builtin_amdgcn_update_dpp(0, __builtin_bit_cast(int, v), 0xB1, 0xF, 0xF, false)); }
__device__ __forceinline__ float dpp_x2(float v) { return __builtin_bit_cast(float, __builtin_amdgcn_update_dpp(0, __builtin_bit_cast(int, v), 0x4E, 0xF, 0xF, false)); }
__device__ __forceinline__ float dpp_hm(float v) { return __builtin_bit_cast(float, __builtin_amdgcn_update_dpp(0, __builtin_bit_cast(int, v), 0x141, 0xF, 0xF, false)); }
__device__ __forceinline__ float wave_sum(float v, int lane) {
#pragma unroll
    for (int o = 1; o < 64; o <<= 1) v += shx(v, o, lane);
    return v;
}
__device__ __forceinline__ float wave_max(float v, int lane) {
#pragma unroll
    for (int o = 1; o < 64; o <<= 1) v = fmaxf(v, shx(v, o, lane));
    return v;
}
__device__ __forceinline__ unsigned f2bf(float f) { unsigned u = __builtin_bit_cast(unsigned, f); return (u + 0x7fffu + ((u >> 16) & 1u)) >> 16; }
__device__ __forceinline__ unsigned pk2(float lo, float hi) { return f2bf(lo) | (f2bf(hi) << 16); }
__device__ __forceinline__ float bf2f(bf16 b) { return __builtin_bit_cast(float, (unsigned)b << 16); }
__device__ __forceinline__ float silu_f(float g) { return g * __builtin_amdgcn_rcpf(1.0f + __expf(-g)); }

template <class T> __device__ __forceinline__ T* uptr(T* p) {
    unsigned long long v = (unsigned long long)p;
    const unsigned lo = __builtin_amdgcn_readfirstlane((unsigned)v), hi = __builtin_amdgcn_readfirstlane((unsigned)(v >> 32));
    return (T*)(((unsigned long long)hi << 32) | lo);
}
namespace pg8 {
struct EpiSwiGLU {
    static constexpr bool PERM = true, AFTER_DRAIN = false;
    bf16_t* O;
    __device__ __forceinline__ void operator()(const f32x4 (&acc)[2][2][4][2], const Unit& u, int wr, int wc, int fr, int fq) const {
        const int row0 = u.pm * BM + wr * 64 + fr, col0 = u.pn * HALF + wc * 32 + 8 * fq;
#pragma unroll
        for (int ai = 0; ai < 2; ++ai)
#pragma unroll
            for (int m = 0; m < 4; ++m) {
                bf16_t* rowp = O + (size_t)(row0 + ai * HALF + m * 16) * DFF + col0;
                const f32x4 g0 = acc[ai][0][m][0], g1 = acc[ai][0][m][1], u0 = acc[ai][1][m][0], u1 = acc[ai][1][m][1];
                u32x4 w;
                w.x = cvt_pk_bf16(silu_f(g0[0]) * u0[0], silu_f(g0[1]) * u0[1]);
                w.y = cvt_pk_bf16(silu_f(g0[2]) * u0[2], silu_f(g0[3]) * u0[3]);
                w.z = cvt_pk_bf16(silu_f(g1[0]) * u1[0], silu_f(g1[1]) * u1[1]);
                w.w = cvt_pk_bf16(silu_f(g1[2]) * u1[2], silu_f(g1[3]) * u1[3]);
                *(u32x4*)rowp = w;
            }
    }
};
struct EpiResid {
    static constexpr bool PERM = true, AFTER_DRAIN = false;
    const bf16_t* xin; bf16_t* xout; float* fout; const float* modl; int kmod; float coef;
    __device__ __forceinline__ void operator()(const f32x4 (&acc)[2][2][4][2], const Unit& u, int wr, int wc, int fr, int fq) const {
        const int rowt = u.pm * BM; const int mr = rowt < MLAT ? (rowt >> 11) : 8;
        const float* gv = modl + (size_t)mr * (NMOD * DM) + kmod * DM;
        const int col0 = u.pn * BM + wc * 32 + 8 * fq;
        f32x4 g[2][2];
#pragma unroll
        for (int bj = 0; bj < 2; ++bj)
#pragma unroll
            for (int n = 0; n < 2; ++n) g[bj][n] = *(const f32x4*)(gv + col0 + bj * HALF + 4 * n) * coef;
        float* part = (float*)((char*)const_cast<bf16_t*>(xin) + ((long long)WS_PART - (long long)WS_X));
        if (u.ntk != (kmod == 5 ? DM / 64 : DFF / 64)) {
#pragma unroll
            for (int ai = 0; ai < 2; ++ai)
#pragma unroll
                for (int m = 0; m < 4; ++m) {
                    bf16_t* pp = (bf16_t*)part + ((size_t)u.part * MCTX + (rowt - MLAT + ai * HALF + wr * 64 + m * 16 + fr)) * DM + col0;
#pragma unroll
                    for (int bj = 0; bj < 2; ++bj) { const f32x4 y0 = g[bj][0] * acc[ai][bj][m][0], y1 = g[bj][1] * acc[ai][bj][m][1];
                        u32x4 o; o.x = cvt_pk_bf16(y0[0], y0[1]); o.y = cvt_pk_bf16(y0[2], y0[3]); o.z = cvt_pk_bf16(y1[0], y1[1]); o.w = cvt_pk_bf16(y1[2], y1[3]); *(u32x4*)(pp + bj * HALF) = o; }
                }
            return;
        }
#pragma unroll
        for (int ai = 0; ai < 2; ++ai) {
            u32x4 xb[4][2];
#pragma unroll
            for (int m = 0; m < 4; ++m)
#pragma unroll
                for (int bj = 0; bj < 2; ++bj) xb[m][bj] = *(const u32x4*)(xin + (size_t)(rowt + ai * HALF + wr * 64 + m * 16 + fr) * DM + col0 + bj * HALF);
#pragma unroll
            for (int m = 0; m < 4; ++m) {
                const size_t off = (size_t)(rowt + ai * HALF + wr * 64 + m * 16 + fr) * DM + col0;
#pragma unroll
                for (int bj = 0; bj < 2; ++bj) {
                    const u32x4 x = xb[m][bj];
                    const f32x4 x0 = {__builtin_bit_cast(float, x.x << 16), __builtin_bit_cast(float, x.x & 0xffff0000u), __builtin_bit_cast(float, x.y << 16), __builtin_bit_cast(float, x.y & 0xffff0000u)};
                    const f32x4 x1 = {__builtin_bit_cast(float, x.z << 16), __builtin_bit_cast(float, x.z & 0xffff0000u), __builtin_bit_cast(float, x.w << 16), __builtin_bit_cast(float, x.w & 0xffff0000u)};
                    const f32x4 y0 = x0 + g[bj][0] * acc[ai][bj][m][0], y1 = x1 + g[bj][1] * acc[ai][bj][m][1];
                    if (fout) { *(f32x4*)(fout + off + bj * HALF) = y0; *(f32x4*)(fout + off + bj * HALF + 4) = y1; }
                    else { u32x4 o; o.x = cvt_pk_bf16(y0[0], y0[1]); o.y = cvt_pk_bf16(y0[2], y0[3]); o.z = cvt_pk_bf16(y1[0], y1[1]); o.w = cvt_pk_bf16(y1[2], y1[3]); *(u32x4*)(xout + off + bj * HALF) = o; }
                }
            }
            asm volatile("" ::: "memory");
        }
    }
};
struct BdOrder {
    StaticOrder base; bool bd;
    __device__ void init(int M, int N, int G_, int c_, int K_, bool bd_) { base.init(M, N, G_, c_, K_); bd = bd_; }
    __device__ bool next(int i, Unit& u) const {
        if (!base.next(i, u)) return false;
        if (bd) { if (u.pn < 3) { u.kt0 = 0; u.ntk = 6; } else { u.kt0 = 6; u.ntk = 4; } }
        return true;
    }
    __device__ __forceinline__ void a_ready(const Unit&) const {}
    __device__ __forceinline__ void done(const Unit&) const {}
};
struct LatCtxOrder {
    StaticOrder lat, all; int G, c, nlr, nseg, S, npairs; bool plain;
    __device__ void init(int M, int G_, int c_, int K_, int S_) {
        lat.init(MLAT, DM, G_, c_, K_); all.init(M, DM, G_, c_, K_); G = G_; c = c_; S = S_; npairs = K_ / (2 * BK);
        plain = (lat.nwg % G_) != 0 || M <= MLAT; nlr = lat.nwg / G_; nseg = ((M - MLAT) / BM) * 4 * S_;
    }
    __device__ bool next(int i, Unit& u) const {
        if (plain) return all.next(i, u);
        if (i < nlr) return lat.next(i, u);
        const int sidx = (i - nlr) * G + c; if (sidx >= nseg) return false;
        const int tile = sidx / S, part = sidx % S, p0 = part * npairs / S, p1 = (part + 1) * npairs / S;
        u.pm = MLAT / BM + (tile >> 2); u.pn = tile & 3; u.kt0 = 2 * p0; u.ntk = 2 * (p1 - p0); u.part = part; return true;
    }
    __device__ __forceinline__ void a_ready(const Unit&) const {}
    __device__ __forceinline__ void done(const Unit&) const {}
};
}


typedef short bf16x8 __attribute__((ext_vector_type(8)));
typedef short s16x4 __attribute__((ext_vector_type(4)));
typedef float f32x16 __attribute__((ext_vector_type(16)));
__device__ __forceinline__ int crow(int r, int hi) { return (r & 3) + 8 * (r >> 2) + 4 * hi; }
typedef float f32x2_t __attribute__((ext_vector_type(2))); typedef __bf16 bf16x2_t __attribute__((ext_vector_type(2)));
__device__ __forceinline__ unsigned cvtpk(float lo, float hi) { f32x2_t v = {lo, hi}; bf16x2_t b = __builtin_convertvector(v, bf16x2_t); return __builtin_bit_cast(unsigned, b); }
constexpr int AT_KBUF = 26624, AT_VBUF = 16384, AT_VOFF = 2 * AT_KBUF, AT_WSF = AT_VOFF + 2 * AT_VBUF;
template <int DK>
__device__ __forceinline__ void attn_unit(LAS unsigned char* lds, const GAS bf16* Qp, const GAS bf16* Kp, const GAS bf16* Vp, GAS bf16* Yp, int b, int j, int nkeys, int tid, int lane, int wave) {
    constexpr int KSTR = DK * 2 + 16, ND = DK / 16, CPR = DK / 8, NKC = CPR / 4;
    const int r32 = lane & 31, hi = lane >> 5;
    bf16x8 qr[ND];
    { const GAS bf16* Qw = Qp + (size_t)(256 * j + wave * 32 + r32) * DK + hi * 8;
#pragma unroll
      for (int d0 = 0; d0 < ND; ++d0) qr[d0] = *(const GAS bf16x8*)(Qw + d0 * 16); }
    int koff[NKC], voff[2];
#pragma unroll
    for (int i = 0; i < NKC; ++i) { const int kc = tid + 512 * i; koff[i] = (kc / CPR) * KSTR + (kc % CPR) * 16; }
#pragma unroll
    for (int i = 0; i < 2; ++i) { const int vc = tid + 512 * i, vrow = vc >> 3, vch = vc & 7; voff[i] = AT_VOFF + (vch >> 2) * 8192 + (vrow >> 4) * 1024 + (vrow & 15) * 64 + (vch & 3) * 16; }
    const int NT = nkeys >> 7;
    u32x4 kreg[NKC], vreg[2];
#define AT_LOAD(t) do { const GAS u32x4* Kg_ = (const GAS u32x4*)(Kp + (size_t)(t) * 128 * DK); const GAS u32x4* Vg_ = (const GAS u32x4*)(Vp + (size_t)(t) * 128 * 64); \
        _Pragma("unroll") for (int i_ = 0; i_ < NKC; ++i_) kreg[i_] = Kg_[tid + 512 * i_]; vreg[0] = Vg_[tid]; vreg[1] = Vg_[tid + 512]; } while (0)
#define AT_STORE(bf_) do { LAS unsigned char* nb_ = lds + (bf_) * AT_KBUF; _Pragma("unroll") for (int i_ = 0; i_ < NKC; ++i_) *(LAS u32x4*)(nb_ + koff[i_]) = kreg[i_]; \
        *(LAS u32x4*)(lds + (bf_) * AT_VBUF + voff[0]) = vreg[0]; *(LAS u32x4*)(lds + (bf_) * AT_VBUF + voff[1]) = vreg[1]; } while (0)
    AT_LOAD(0); AT_STORE(0);
    if (NT > 1) AT_LOAD(1);
    __syncthreads();
    LAS float* wsf = (LAS float*)(lds + AT_WSF) + wave * 32;
    float mhat = 0.f;
    f32x16 o0, o1, ol, negm;
#pragma unroll
    for (int r = 0; r < 16; ++r) { o0[r] = 0.f; o1[r] = 0.f; ol[r] = 0.f; negm[r] = 0.f; }
    const bf16x8 ones = {0x3F80, 0x3F80, 0x3F80, 0x3F80, 0x3F80, 0x3F80, 0x3F80, 0x3F80};
    const int kfo = r32 * KSTR + hi * 16;
    const int vfo = AT_VOFF + (4 * hi + ((lane & 15) >> 2)) * 64 + ((lane >> 4) & 1) * 32 + (lane & 3) * 8;
    for (int t = 0; t < NT; ++t) {
        const int cur = t & 1;
        f32x16 p[4];
        { LAS unsigned char* kb = lds + cur * AT_KBUF + kfo;
          bf16x8 ka[2][4];
#pragma unroll
          for (int q4 = 0; q4 < 4; ++q4) ka[0][q4] = *(LAS bf16x8*)(kb + q4 * 32 * KSTR);
#pragma unroll
          for (int d0 = 0; d0 < ND; ++d0) {
              if (d0 + 1 < ND) {
#pragma unroll
                  for (int q4 = 0; q4 < 4; ++q4) ka[(d0 + 1) & 1][q4] = *(LAS bf16x8*)(kb + q4 * 32 * KSTR + (d0 + 1) * 32);
              }
#pragma unroll
              for (int q4 = 0; q4 < 4; ++q4) p[q4] = __builtin_amdgcn_mfma_f32_32x32x16_bf16(ka[d0 & 1][q4], qr[d0], d0 == 0 ? negm : p[q4], 0, 0, 0);
              if (d0 == 0) { if (t + 1 < NT) AT_STORE(cur ^ 1); if (t + 2 < NT) AT_LOAD(t + 2); }
              __builtin_amdgcn_sched_barrier(0);
          } }
        float rma = fmaxf(p[0][0], p[1][0]), rmb = fmaxf(p[2][0], p[3][0]);
#pragma unroll
        for (int r = 1; r < 16; ++r) { rma = fmaxf(fmaxf(rma, p[0][r]), p[1][r]); rmb = fmaxf(fmaxf(rmb, p[2][r]), p[3][r]); }
        float rm = fmaxf(rma, rmb);
        { const unsigned ru_ = __builtin_bit_cast(unsigned, rm); auto rr_ = __builtin_amdgcn_permlane32_swap(ru_, ru_, false, false);
          rm = fmaxf(__builtin_bit_cast(float, (unsigned)rr_[0]), __builtin_bit_cast(float, (unsigned)rr_[1])); }
        if (t == 0 || __any(rm > 8.0f)) {
            const float dl = (t == 0) ? rm : fmaxf(rm, 0.f), f = __builtin_amdgcn_exp2f(-dl);
            mhat += dl;
#pragma unroll
            for (int r = 0; r < 16; ++r) { p[0][r] -= dl; p[1][r] -= dl; p[2][r] -= dl; p[3][r] -= dl; negm[r] = -mhat; }
            if (hi == 0) wsf[r32] = f;
            asm volatile("s_waitcnt lgkmcnt(0)" ::: "memory");
#pragma unroll
            for (int r = 0; r < 16; ++r) { const float fr = wsf[crow(r, hi)]; o0[r] *= fr; o1[r] *= fr; ol[r] *= fr; }
            asm volatile("s_waitcnt lgkmcnt(0)" ::: "memory");
        }
        u32x4 pw[8];
        { LAS unsigned char* vb = lds + cur * AT_VBUF + vfo;
#define AT_VF(d0, ks) ({ const s16x4 lo_ = __builtin_bit_cast(s16x4, __builtin_amdgcn_ds_read_tr16_b64_v4i16((LAS s16x4*)(vb + (d0) * 8192 + (ks) * 1024))); \
                         const s16x4 hi_ = __builtin_bit_cast(s16x4, __builtin_amdgcn_ds_read_tr16_b64_v4i16((LAS s16x4*)(vb + (d0) * 8192 + (ks) * 1024 + 512))); \
                         (bf16x8){lo_[0], lo_[1], lo_[2], lo_[3], hi_[0], hi_[1], hi_[2], hi_[3]}; })
#define AT_EXPQ(q4) do { _Pragma("unroll") for (int r = 0; r < 16; ++r) p[q4][r] = __builtin_amdgcn_exp2f(p[q4][r]); \
            pw[2 * (q4)] = (u32x4){cvtpk(p[q4][0], p[q4][1]), cvtpk(p[q4][2], p[q4][3]), cvtpk(p[q4][4], p[q4][5]), cvtpk(p[q4][6], p[q4][7])}; \
            pw[2 * (q4) + 1] = (u32x4){cvtpk(p[q4][8], p[q4][9]), cvtpk(p[q4][10], p[q4][11]), cvtpk(p[q4][12], p[q4][13]), cvtpk(p[q4][14], p[q4][15])}; } while (0)
#define AT_PVK(ks, VF) do { o0 = __builtin_amdgcn_mfma_f32_32x32x16_bf16(__builtin_bit_cast(bf16x8, pw[ks]), VF[0], o0, 0, 0, 0); \
            o1 = __builtin_amdgcn_mfma_f32_32x32x16_bf16(__builtin_bit_cast(bf16x8, pw[ks]), VF[1], o1, 0, 0, 0); \
            ol = __builtin_amdgcn_mfma_f32_32x32x16_bf16(__builtin_bit_cast(bf16x8, pw[ks]), ones, ol, 0, 0, 0); } while (0)
          bf16x8 vfa[2], vfb[2];
          vfa[0] = AT_VF(0, 0); vfa[1] = AT_VF(1, 0);
          AT_EXPQ(0);
          __builtin_amdgcn_sched_barrier(0);
#pragma unroll
          for (int q4 = 0; q4 < 4; ++q4) {
              vfb[0] = AT_VF(0, 2 * q4 + 1); vfb[1] = AT_VF(1, 2 * q4 + 1);
              AT_PVK(2 * q4, vfa);
              if (q4 + 1 < 4) { AT_EXPQ(q4 + 1); vfa[0] = AT_VF(0, 2 * q4 + 2); vfa[1] = AT_VF(1, 2 * q4 + 2); }
              AT_PVK(2 * q4 + 1, vfb);
              __builtin_amdgcn_sched_barrier(0);
          }
#undef AT_EXPQ
#undef AT_PVK
#undef AT_VF
        }
        __syncthreads();
    }
#undef AT_LOAD
#undef AT_STORE
    const int pos0 = 256 * j + wave * 32;
#pragma unroll
    for (int r = 0; r < 16; ++r) {
        const int qq = crow(r, hi); const float inv = __builtin_amdgcn_rcpf(ol[r]); const int pos = pos0 + qq;
        const int row = (j == 0) ? MLAT + b * CTXL + pos : b * SEQ + pos - CTXL;
        GAS bf16* yp = Yp + (size_t)row * DM + r32;
        yp[0] = (bf16)f2bf(o0[r] * inv); yp[32] = (bf16)f2bf(o1[r] * inv);
    }
    asm volatile("s_waitcnt lgkmcnt(0)" ::: "memory");
    __syncthreads();
}

#define XB_TMO      128
#define XB_XCNT(j)  (256  + 64 * (j))
#define XB_XSUB(j)  (1280 + 64 * (j))
#define XB_XGEN(j)  (2304 + 64 * (j))
#define XB_TOP      3328
#define XB_TOPGEN   3392
#define XCD_BAR_WORDS 3456
#define XB_SPIN_CAP (1u << 18)

__device__ __forceinline__ unsigned xb_ld(unsigned* p)              { return __hip_atomic_load(p, __ATOMIC_RELAXED, __HIP_MEMORY_SCOPE_AGENT); }
__device__ __forceinline__ unsigned xb_add(unsigned* p, unsigned v) { return __hip_atomic_fetch_add(p, v, __ATOMIC_RELAXED, __HIP_MEMORY_SCOPE_AGENT); }
__device__ __forceinline__ unsigned xb_xcc_id() { return (unsigned)__builtin_amdgcn_s_getreg((3 << 11) | 20) & 0xFu; }
#define XB_SPIN(cond, bar) do { unsigned _sp = 0; while (cond) { __builtin_amdgcn_s_sleep(1); \
    if ((++_sp & 255u) == 0u) { if (xb_ld(&(bar)[XB_TMO])) break; if (_sp > XB_SPIN_CAP) { atomicAdd(&(bar)[XB_TMO], 1u); break; } } } } while (0)

struct XcdBarrier {
    unsigned* bar; unsigned x;
    volatile LAS unsigned* st;
};

__device__ __forceinline__ XcdBarrier xcd_barrier_post(unsigned* bar, volatile LAS unsigned* st) {
    XcdBarrier b; b.bar = bar; b.x = xb_xcc_id(); b.st = st;
    if (threadIdx.x == 0) (void)xb_add(&bar[XB_XCNT(b.x)], 1u);
    return b;
}
__device__ __forceinline__ void xcd_barrier_complete(unsigned* bar, unsigned x, unsigned& nloc, unsigned& nx) {
    const unsigned G = gridDim.x * gridDim.y * gridDim.z;
    unsigned sum, cnt, mine, sp = 0u;
    for (;;) {
        sum = 0u; cnt = 0u; mine = 0u;
#pragma unroll
        for (unsigned j = 0; j < 16; ++j) { const unsigned c = xb_ld(&bar[XB_XCNT(j)]); sum += c; cnt += (c > 0u) ? 1u : 0u; mine = (j == x) ? c : mine; }
        if (sum == G) break;
        __builtin_amdgcn_s_sleep(1);
        if ((++sp & 255u) == 0u) { if (xb_ld(&bar[XB_TMO])) break; if (sp > XB_SPIN_CAP) { atomicAdd(&bar[XB_TMO], 1u); break; } }
    }
    nloc = mine > 0u ? mine : 1u; nx = cnt > 0u ? cnt : 1u;
}

__device__ __forceinline__ void xcd_barrier(const XcdBarrier& b) {
    asm volatile("s_waitcnt vmcnt(0)" ::: "memory");
    __syncthreads();
    if (threadIdx.x == 0) {
        unsigned* bar = b.bar;
        __builtin_amdgcn_s_waitcnt(0);
        unsigned nloc = b.st[0], nx = b.st[1];
        if (nloc == 0u) { xcd_barrier_complete(bar, b.x, nloc, nx); b.st[0] = nloc; b.st[1] = nx; }
        const unsigned old = xb_add(&bar[XB_XSUB(b.x)], 1u);
        const unsigned gen = old / nloc;
        if (old + 1u == (gen + 1u) * nloc) {
            __builtin_amdgcn_fence(__ATOMIC_RELEASE, "agent");
            asm volatile("s_waitcnt vmcnt(0)" ::: "memory");
            const unsigned og = xb_add(&bar[XB_TOP], 1u);
            const unsigned tg = og / nx;
            if (og + 1u == (tg + 1u) * nx) xb_add(&bar[XB_TOPGEN], 1u);
            else XB_SPIN(xb_ld(&bar[XB_TOPGEN]) == tg, bar);
            __builtin_amdgcn_fence(__ATOMIC_ACQUIRE, "agent");
            xb_add(&bar[XB_XGEN(b.x)], 1u);
            asm volatile("s_waitcnt vmcnt(0)" ::: "memory");
        } else {
            XB_SPIN(xb_ld(&bar[XB_XGEN(b.x)]) == gen, bar);
            __builtin_amdgcn_fence(__ATOMIC_ACQUIRE, "agent");
            asm volatile("s_waitcnt vmcnt(0)" ::: "memory");
        }
    }
    __syncthreads();
}

struct Args { const float* in[24]; float* out; unsigned char* ws; int ph_lo, ph_hi; };

__device__ __forceinline__ int drow_of(int n, int rmode) {
    return rmode == 0 ? n : (rmode == 1 ? 256 * (n >> 7) + (n & 127) : (rmode == 2 ? 256 * (n >> 7) + 128 + (n & 127) : 128 * (n / 96) + (n % 96)));
}
__device__ __forceinline__ void transpose_item(const float* Wg, int K, int N, bf16* WTg, int pitch, int rmode, LAS float* scr, int item, int lane) {
    const GAS float* W = (const GAS float*)Wg; GAS bf16* WT = (GAS bf16*)WTg;
    const int nblk = (N + 63) >> 6, kb = item / nblk, nb = item % nblk, k0 = 64 * kb, n0 = 64 * nb;
    const bool valid = n0 + lane < N;
    const GAS float* src = W + (size_t)k0 * N + n0 + lane;
    float val[64];
#pragma unroll
    for (int i = 0; i < 64; ++i) val[i] = valid ? src[(size_t)i * N] : 0.f;
#pragma unroll
    for (int i = 0; i < 64; ++i) scr[i * 65 + lane] = val[i];
    asm volatile("s_waitcnt lgkmcnt(0)" ::: "memory");
    const int c = lane & 7;
#pragma unroll
    for (int j = 0; j < 8; ++j) { const int nl = (lane >> 3) + 8 * j, n = n0 + nl; const LAS float* sp_ = scr + (8 * c) * 65 + nl;
        u32x4 o; o.x = pk2(sp_[0 * 65], sp_[1 * 65]); o.y = pk2(sp_[2 * 65], sp_[3 * 65]); o.z = pk2(sp_[4 * 65], sp_[5 * 65]); o.w = pk2(sp_[6 * 65], sp_[7 * 65]);
        if (n < N) *(GAS u32x4*)(WT + (size_t)drow_of(n, rmode) * pitch + k0 + 8 * c) = o; }
    asm volatile("s_waitcnt lgkmcnt(0)" ::: "memory");
}

__device__ __forceinline__ float rope_inv64(int i) { return exp2f(-(float)(2 * i) * (L2THETA / 32.0f)); }
__device__ __forceinline__ float rope_inv32(int i) { return exp2f(-(float)(2 * i) * (L2THETA / 16.0f)); }

constexpr int I_FF = 704, I_IN = 528, I_OUT = 256, I_UQ = 54, I_UKV = 48, I_L = 6 * I_FF + I_IN + I_OUT + I_UQ + I_UKV;
__device__ __forceinline__ void convert_item(const Args* ap, unsigned char* ws, int l, int r, LAS float* scr, int lane) {
    const float* W; bf16* WT; int K, N, pitch, rmode, idx;
    if (r < 6 * I_FF) {
        const int j = r / (3 * I_FF), r2 = r % (3 * I_FF), which = r2 / I_FF, lj = l * 2 + j; idx = r2 % I_FF;
        if (which < 2) { W = ap->in[7 + which] + (size_t)lj * DM * DFF; K = DM; N = DFF; WT = (bf16*)(ws + WS_WGU + lj * SZ_WGU); pitch = DM; rmode = 1 + which; }
        else { W = ap->in[9] + (size_t)lj * DFF * DM; K = DFF; N = DM; WT = (bf16*)(ws + WS_WD + lj * SZ_WD); pitch = DFF; rmode = 0; }
    } else {
        r -= 6 * I_FF;
        if (r < I_IN) { W = ap->in[10] + (size_t)l * DM * INC; K = DM; N = INC; WT = (bf16*)(ws + WS_WIN + l * SZ_WIN); pitch = DM; rmode = 0; idx = r; }
        else if (r < I_IN + I_OUT) { W = ap->in[11] + (size_t)l * DM * DM; K = DM; N = DM; WT = (bf16*)(ws + WS_WOUT + l * SZ_WOUT); pitch = DM; rmode = 0; idx = r - I_IN; }
        else if (r < I_IN + I_OUT + I_UQ) { W = ap->in[18] + (size_t)l * 384 * 576; K = 384; N = 576; WT = (bf16*)(ws + WS_WUP + l * SZ_WUP); pitch = 640; rmode = 3; idx = r - I_IN - I_OUT; }
        else { W = ap->in[19] + (size_t)l * 256 * 768; K = 256; N = 768; WT = (bf16*)(ws + WS_WUP + l * SZ_WUP) + (size_t)768 * 640 + 384; pitch = 640; rmode = 0; idx = r - I_IN - I_OUT - I_UQ; }
    }
    transpose_item(W, K, N, WT, pitch, rmode, scr, idx, lane);
}

__global__ void __launch_bounds__(512, 2) fwd_mega(Args args) {
    extern __shared__ __attribute__((aligned(16))) unsigned char lds[];
    cg::grid_group grid = cg::this_grid();
    LAS unsigned char* ldsl = (LAS unsigned char*)lds;

    const int ph_lo = args.ph_lo, ph_hi = args.ph_hi;
    volatile LAS unsigned* xst = (volatile LAS unsigned*)((LAS unsigned char*)lds + LDS_BYTES - 64);
    if (threadIdx.x == 0) { xst[0] = 0u; xst[1] = 0u; }
    __syncthreads();
    const XcdBarrier xbar = xcd_barrier_post((unsigned*)(args.ws + WS_CTL), xst);
    const int wave0 = __builtin_amdgcn_readfirstlane(threadIdx.x >> 6);
    const Args* ap = (const Args*)__builtin_amdgcn_kernarg_segment_ptr();
#if DBL
    bool redo = false;
#endif
    for (int ph = ph_lo; ph < ph_hi; ++ph) {
        asm volatile("" : "+s"(ap));
        ap = uptr(ap);
        int lane_ = __lane_id(); asm volatile("" : "+v"(lane_));
        const int tid = wave0 * 64 + lane_;
        int G = gridDim.x, bx = blockIdx.x; asm volatile("" : "+s"(G), "+s"(bx));
        const int lane = lane_, wave = wave0;
        const int gw = bx * 8 + wave, NGW = G * 8;
        unsigned char* ws = uptr(ap->ws);
        float* MOD = (float*)(ws + WS_MOD);
        if (ph == 0) { if constexpr ((EN & 1) != 0) {
            {
                LAS float* scr = (LAS float*)(ldsl + wave * 16640);
                for (int it = gw; it < I_L; it += NGW) convert_item(ap, ws, 0, it, scr, lane);
            }
            {
                const GAS f32x4* xs = (const GAS f32x4*)ap->in[0]; const GAS f32x4* cs = (const GAS f32x4*)ap->in[2]; GAS u32x4* xd = (GAS u32x4*)(ws + WS_X);
                const int nl = MLAT * DM / 8, nc = MCTX * DM / 8;
                for (int i = bx * 512 + tid; i < nl; i += G * 512) { const f32x4 a = xs[2 * i], c = xs[2 * i + 1]; xd[i] = (u32x4){cvtpk(a.x, a.y), cvtpk(a.z, a.w), cvtpk(c.x, c.y), cvtpk(c.z, c.w)}; }
                for (int i = bx * 512 + tid; i < nc; i += G * 512) { const f32x4 a = cs[2 * i], c = cs[2 * i + 1]; xd[nl + i] = (u32x4){cvtpk(a.x, a.y), cvtpk(a.z, a.w), cvtpk(c.x, c.y), cvtpk(c.z, c.w)}; }
            }
            {
                for (int i = bx * 512 + tid; i < DEPTH * 1536 * 80; i += G * 512) {
                    const int l = i / (1536 * 80), r2 = i % (1536 * 80), row = r2 / 80, ch = r2 % 80;
                    const bool z = row < 768 ? (ch >= 48) : (ch < 48);
                    if (z) *(u32x4*)((bf16*)(ws + WS_WUP + l * SZ_WUP) + (size_t)row * 640 + ch * 8) = (u32x4){0u, 0u, 0u, 0u};
                }
            }
            __syncthreads();
            {
                LAS float* S = (LAS float*)ldsl;
                LAS float* red = (LAS float*)(ldsl + 36864);
                for (int i = tid; i < 9 * DM; i += 512) { const int r = i >> 10, k = i & 1023; const float v = r < 8 ? ap->in[1][r * DM + k] : ap->in[3][k]; S[i] = v / (1.0f + expf(-v)); }
                __syncthreads();
                for (int item = bx; item < DEPTH * 36; item += G) {
                    const int l = item / 36, n0 = (item % 36) * 256;
                    f32x4 acc[9];
#pragma unroll
                    for (int r = 0; r < 9; ++r) acc[r] = (f32x4){0.f, 0.f, 0.f, 0.f};
                    const GAS float* w = (const GAS float*)ap->in[4] + (size_t)l * DM * (NMOD * DM) + (size_t)(wave * 128) * (NMOD * DM) + n0 + 4 * lane;
#pragma unroll 16
                    for (int kk = 0; kk < 128; ++kk) {
                        const f32x4 wv = *(const GAS f32x4*)(w + (size_t)kk * (NMOD * DM));
#pragma unroll
                        for (int r = 0; r < 9; ++r) acc[r] += wv * S[r * DM + wave * 128 + kk];
                    }
#pragma unroll
                    for (int r = 0; r < 9; ++r) *(LAS f32x4*)(red + (wave * 9 + r) * 256 + 4 * lane) = acc[r];
                    __syncthreads();
                    for (int o = tid; o < 9 * 256; o += 512) {
                        const int r = o >> 8, cc = o & 255; float sm = ap->in[5][l * (NMOD * DM) + n0 + cc];
#pragma unroll
                        for (int k2 = 0; k2 < 8; ++k2) sm += red[(k2 * 9 + r) * 256 + cc];
                        MOD[(size_t)(l * 9 + r) * (NMOD * DM) + n0 + cc] = sm;
                    }
                    __syncthreads();
                }
            }
        } } else {
            const int l = (ph - 1) / 13, sp = (ph - 1) % 13;
            const bool last = (l == DEPTH - 1);
            const float* modl = MOD + (size_t)l * 9 * (NMOD * DM);
            if ((EN & 2) && (sp == 0 || sp == 3 || sp == 10)) {
                const int which = sp == 0 ? 0 : (sp == 3 ? 1 : 2);
                const int kshift = which == 0 ? 0 : (which == 1 ? 3 : 6);
                const int nrows = (sp == 10 && last) ? MLAT : MTOT;
                GAS bf16* X = (GAS bf16*)(ws + WS_X); GAS bf16* Hb = (GAS bf16*)(ws + WS_H);
                const GAS float* gn = (const GAS float*)ap->in[6] + (size_t)(l * 3 + which) * DM;
                float gg[16], am[16], bm[16];
#pragma unroll
                for (int j = 0; j < 2; ++j)
#pragma unroll
                    for (int e = 0; e < 8; ++e) { gg[8 * j + e] = gn[512 * j + 8 * lane + e]; am[8 * j + e] = 0.f; bm[8 * j + e] = 0.f; }
                const int rpc = nrows > MLAT ? (MCTX + NGW - 1) / NGW : 0, rpl = (MLAT + NGW - 1) / NGW, nk = rpc + rpl;
#define ROWOF(k) ((k) < rpc ? ((gw * rpc + (k)) < MCTX ? MLAT + gw * rpc + (k) : -1) : ((gw * rpl + (k) - rpc) < MLAT ? gw * rpl + (k) - rpc : -1))
#define XLOAD(dst, row) do { const GAS u32x4* xr_ = (const GAS u32x4*)(X + (size_t)(row) * DM) + lane; dst[0] = xr_[0]; dst[1] = xr_[64]; } while (0)
                u32x4 va[2], vb[2], vc[2];
                va[0] = va[1] = vb[0] = vb[1] = vc[0] = vc[1] = (u32x4){0u, 0u, 0u, 0u};
                { const int ra = ROWOF(0); if (nk > 0 && ra >= 0) XLOAD(va, ra); }
                { const int rb = ROWOF(1); if (nk > 1 && rb >= 0) XLOAD(vb, rb); }
                int cur_mr = -1;
                const bool haspart = (sp != 0 || l > 0) && (256 % G) == 0;
                u32x4 pq[SPLITS][2];
                const int r_first = ROWOF(0); const bool pf = haspart && nk > 0 && r_first >= MLAT;
#pragma unroll
                for (int sq = 0; sq < SPLITS; ++sq) { pq[sq][0] = (u32x4){0u, 0u, 0u, 0u}; pq[sq][1] = pq[sq][0]; }
                if (pf) {
#pragma unroll
                    for (int sq = 0; sq < SPLITS; ++sq) { const GAS bf16* pr = (const GAS bf16*)(ws + WS_PART) + ((size_t)sq * MCTX + (r_first - MLAT)) * DM + 8 * lane;
                        pq[sq][0] = *(const GAS u32x4*)pr; pq[sq][1] = *(const GAS u32x4*)(pr + 512); } }
                for (int k = 0; k < nk; ++k) {
                    const int r = ROWOF(k);
                    { const int rc = ROWOF(k + 2); if (k + 2 < nk && rc >= 0) XLOAD(vc, rc); }
                    if (r >= 0) {
                    const int mr = r < MLAT ? (r >> 11) : 8;
                    if (mr != cur_mr) { cur_mr = mr; const GAS float* sh = (const GAS float*)modl + (size_t)mr * (NMOD * DM) + kshift * DM; const GAS float* sc = sh + DM;
#pragma unroll
                        for (int j = 0; j < 2; ++j)
#pragma unroll
                            for (int e = 0; e < 8; ++e) { am[8 * j + e] = gg[8 * j + e] * (sc[512 * j + 8 * lane + e] + 1.0f); bm[8 * j + e] = sh[512 * j + 8 * lane + e]; } }
                    float v[16];
#pragma unroll
                    for (int j = 0; j < 2; ++j) { const u32x4 u = va[j];
                        v[8 * j + 0] = __builtin_bit_cast(float, u.x << 16); v[8 * j + 1] = __builtin_bit_cast(float, u.x & 0xffff0000u); v[8 * j + 2] = __builtin_bit_cast(float, u.y << 16); v[8 * j + 3] = __builtin_bit_cast(float, u.y & 0xffff0000u);
                        v[8 * j + 4] = __builtin_bit_cast(float, u.z << 16); v[8 * j + 5] = __builtin_bit_cast(float, u.z & 0xffff0000u); v[8 * j + 6] = __builtin_bit_cast(float, u.w << 16); v[8 * j + 7] = __builtin_bit_cast(float, u.w & 0xffff0000u); }
                    if (haspart && r >= MLAT) {
#pragma unroll
                        for (int sq = 0; sq < SPLITS; ++sq) { const GAS bf16* pr = (const GAS bf16*)(ws + WS_PART) + ((size_t)sq * MCTX + (r - MLAT)) * DM + 8 * lane;
#pragma unroll
                            for (int j = 0; j < 2; ++j) { const u32x4 a = (pf && k == 0) ? pq[sq][j] : *(const GAS u32x4*)(pr + 512 * j);
                                v[8 * j + 0] += __builtin_bit_cast(float, a.x << 16); v[8 * j + 1] += __builtin_bit_cast(float, a.x & 0xffff0000u); v[8 * j + 2] += __builtin_bit_cast(float, a.y << 16); v[8 * j + 3] += __builtin_bit_cast(float, a.y & 0xffff0000u);
                                v[8 * j + 4] += __builtin_bit_cast(float, a.z << 16); v[8 * j + 5] += __builtin_bit_cast(float, a.z & 0xffff0000u); v[8 * j + 6] += __builtin_bit_cast(float, a.w << 16); v[8 * j + 7] += __builtin_bit_cast(float, a.w & 0xffff0000u); } }
                        GAS u32x4* xw = (GAS u32x4*)(X + (size_t)r * DM) + lane;
#pragma unroll
                        for (int j = 0; j < 2; ++j) { const u32x4 o = (u32x4){cvtpk(v[8 * j], v[8 * j + 1]), cvtpk(v[8 * j + 2], v[8 * j + 3]), cvtpk(v[8 * j + 4], v[8 * j + 5]), cvtpk(v[8 * j + 6], v[8 * j + 7])}; xw[64 * j] = o;
                            v[8 * j + 0] = __builtin_bit_cast(float, o.x << 16); v[8 * j + 1] = __builtin_bit_cast(float, o.x & 0xffff0000u); v[8 * j + 2] = __builtin_bit_cast(float, o.y << 16); v[8 * j + 3] = __builtin_bit_cast(float, o.y & 0xffff0000u);
                            v[8 * j + 4] = __builtin_bit_cast(float, o.z << 16); v[8 * j + 5] = __builtin_bit_cast(float, o.z & 0xffff0000u); v[8 * j + 6] = __builtin_bit_cast(float, o.w << 16); v[8 * j + 7] = __builtin_bit_cast(float, o.w & 0xffff0000u); }
                    }
                    float ss = 0.f;
#pragma unroll
                    for (int e = 0; e < 16; ++e) ss += v[e] * v[e];
                    const float rstd = rsqrtf(wave_sum(ss, lane) * (1.0f / DM) + EPS);
                    GAS u32x4* o8 = (GAS u32x4*)(Hb + (size_t)r * DM) + lane;
#pragma unroll
                    for (int j = 0; j < 2; ++j) { float y[8];
#pragma unroll
                        for (int e = 0; e < 8; ++e) y[e] = v[8 * j + e] * rstd * am[8 * j + e] + bm[8 * j + e];
                        o8[64 * j] = (u32x4){cvtpk(y[0], y[1]), cvtpk(y[2], y[3]), cvtpk(y[4], y[5]), cvtpk(y[6], y[7])}; }
                    }
                    va[0] = vb[0]; va[1] = vb[1]; vb[0] = vc[0]; vb[1] = vc[1];
                }
#undef ROWOF
#undef XLOAD
            } else if ((EN & 32) && sp == 5) {
                const GAS bf16* P = (const GAS bf16*)(ws + WS_P);
                GAS bf16* CQKV = (GAS bf16*)(ws + WS_CQKV); GAS bf16* QA = (GAS bf16*)(ws + WS_QA); GAS bf16* KA = (GAS bf16*)(ws + WS_KA);
                GAS bf16* VA = (GAS bf16*)(ws + WS_VA); GAS bf16* KM = (GAS bf16*)(ws + WS_KM); GAS bf16* YC = (GAS bf16*)(ws + WS_YC);
                const int hh = lane >> 3, dim0 = (lane & 7) * 8;
                float g8[8], inv8[8], ik8[8], gkr8[8], gc0[8], gc1[8], cw0[4], cw1[4], cw2[4], cb4[4];
                { const float* gsrc = (hh < 6 ? ap->in[12] : ap->in[13]) + l * 64 + dim0;
                  const float* gcq = ap->in[16] + l * 384; const float* gckv = ap->in[17] + l * 256; const float* gkr = ap->in[23] + l * 32 + (lane & 3) * 8;
                  const float* cw = ap->in[14] + l * 3 * 256 + 4 * lane; const float* cb = ap->in[15] + l * 256 + 4 * lane;
#pragma unroll
                  for (int e = 0; e < 8; ++e) { g8[e] = gsrc[e] * (hh < 6 ? QSCALE_A : 1.0f); inv8[e] = rope_inv64((lane & 1) * 8 + e); ik8[e] = rope_inv32(e); gkr8[e] = gkr[e];
                      gc0[e] = lane < 48 ? gcq[8 * lane + e] : gckv[8 * (lane - 48) + e]; gc1[e] = gckv[128 + 8 * (lane & 15) + e]; }
#pragma unroll
                  for (int i = 0; i < 4; ++i) { cw0[i] = cw[i]; cw1[i] = cw[256 + i]; cw2[i] = cw[512 + i]; cb4[i] = cb[i]; } }
#define UNPK8(u, f) do { f[0] = __builtin_bit_cast(float, (u).x << 16); f[1] = __builtin_bit_cast(float, (u).x & 0xffff0000u); f[2] = __builtin_bit_cast(float, (u).y << 16); f[3] = __builtin_bit_cast(float, (u).y & 0xffff0000u); \
                          f[4] = __builtin_bit_cast(float, (u).z << 16); f[5] = __builtin_bit_cast(float, (u).z & 0xffff0000u); f[6] = __builtin_bit_cast(float, (u).w << 16); f[7] = __builtin_bit_cast(float, (u).w & 0xffff0000u); } while (0)
#define PK8(f) ((u32x4){cvtpk(f[0], f[1]), cvtpk(f[2], f[3]), cvtpk(f[4], f[5]), cvtpk(f[6], f[7])})
                for (int r = gw; r < MTOT; r += NGW) {
                    const bool lat = r < MLAT; int b, s;
                    if (lat) { b = r >> 11; s = r & 2047; } else { b = (r - MLAT) >> 8; s = (r - MLAT) & 255; }
                    const int pos = lat ? CTXL + s : s, smax = lat ? SEQ - 1 : CTXL - 1;
                    const float prow = (float)(s >> 6), pcol = (float)(s & 63);
                    const GAS bf16* p = P + (size_t)r * INP;
                    const u32x4 a8 = *(const GAS u32x4*)(p + 8 * lane);
                    const u32x4 v8 = *(const GAS u32x4*)(p + PC_V + 8 * (lane & 15));
                    const u32x4 c0 = *(const GAS u32x4*)(p + PC_CQ + 8 * lane);
                    const u32x4 c1 = *(const GAS u32x4*)(p + PC_CQ + 512 + 8 * (lane & 15));
                    const u32x4 k8 = *(const GAS u32x4*)(p + PC_KR + 8 * (lane & 3));
                    const u32x2 xi = *(const GAS u32x2*)(p + PC_X + 4 * lane), cg = *(const GAS u32x2*)(p + PC_CG + 4 * lane), bg = *(const GAS u32x2*)(p + PC_BG + 4 * lane);
                    u32x2 xm = (u32x2){0u, 0u}, cm = xm, xp = xm, cp = xm;
                    if (s > 0) { xm = *(const GAS u32x2*)(p - INP + PC_X + 4 * lane); cm = *(const GAS u32x2*)(p - INP + PC_CG + 4 * lane); }
                    if (s < smax) { xp = *(const GAS u32x2*)(p + INP + PC_X + 4 * lane); cp = *(const GAS u32x2*)(p + INP + PC_CG + 4 * lane); }
                    { float v[8]; UNPK8(a8, v); float ss = 0.f;
#pragma unroll
                      for (int e = 0; e < 8; ++e) ss += v[e] * v[e];
                      ss += dpp_x1(ss); ss += dpp_x2(ss); ss += dpp_hm(ss);
                      const float rs = rsqrtf(ss * (1.0f / 64.0f) + EPS);
#pragma unroll
                      for (int e = 0; e < 8; ++e) v[e] = v[e] * rs * g8[e];
                      if (lat) { const float posv = (lane & 7) < 4 ? prow : pcol;
#pragma unroll
                          for (int e = 0; e < 8; ++e) { const float ang = posv * inv8[e], c = __cosf(ang), sn = __sinf(ang); const float yp = dpp_x2(v[e]);
                              v[e] = (lane & 2) ? v[e] * c + yp * sn : v[e] * c - yp * sn; } }
                      GAS bf16* dst = hh < 6 ? QA + ((size_t)(b * 6 + hh) * LKV + pos) * 64 + dim0 : KA + ((size_t)(b * 2 + hh - 6) * LKV + pos) * 64 + dim0;
                      *(GAS u32x4*)dst = PK8(v); }
                    if (lane < 16) *(GAS u32x4*)(VA + ((size_t)(b * 2 + (lane >> 3)) * LKV + pos) * 64 + (lane & 7) * 8) = v8;
                    { float w[8]; UNPK8(k8, w); float ss = 0.f;
#pragma unroll
                      for (int e = 0; e < 8; ++e) ss += w[e] * w[e];
                      ss += dpp_x1(ss); ss += dpp_x2(ss);
                      const float rs = rsqrtf(ss * (1.0f / 32.0f) + EPS);
#pragma unroll
                      for (int e = 0; e < 8; ++e) w[e] = w[e] * rs * gkr8[e];
                      if (lat) { const float posv = (lane & 3) < 2 ? prow : pcol;
#pragma unroll
                          for (int e = 0; e < 8; ++e) { const float ang = posv * ik8[e], c = __cosf(ang), sn = __sinf(ang); const float zp = dpp_x1(w[e]);
                              w[e] = (lane & 1) ? w[e] * c + zp * sn : w[e] * c - zp * sn; } }
                      if (lane < 24) *(GAS u32x4*)(KM + ((size_t)(b * 6 + (lane >> 2)) * LKV + pos) * 96 + 64 + (lane & 3) * 8) = PK8(w); }
                    { float q0[8], q1[8]; UNPK8(c0, q0); UNPK8(c1, q1); float s0 = 0.f, s1 = 0.f;
#pragma unroll
                      for (int e = 0; e < 8; ++e) { s0 += q0[e] * q0[e]; s1 += q1[e] * q1[e]; }
                      const float sq = wave_sum(lane < 48 ? s0 : 0.f, lane), sk = wave_sum((lane >= 48 ? s0 : 0.f) + (lane < 16 ? s1 : 0.f), lane);
                      const float rq = rsqrtf(sq * (1.0f / 384.0f) + EPS), rk = rsqrtf(sk * (1.0f / 256.0f) + EPS), r0 = lane < 48 ? rq : rk;
#pragma unroll
                      for (int e = 0; e < 8; ++e) { q0[e] = q0[e] * r0 * gc0[e]; q1[e] = q1[e] * rk * gc1[e]; }
                      *(GAS u32x4*)(CQKV + (size_t)r * 640 + 8 * lane) = PK8(q0);
                      if (lane < 16) *(GAS u32x4*)(CQKV + (size_t)r * 640 + 512 + 8 * lane) = PK8(q1); }
                    { float y[4];
#pragma unroll
                      for (int i = 0; i < 4; ++i) {
                          const unsigned xw = i < 2 ? xi.x : xi.y, cgw = i < 2 ? cg.x : cg.y, bgw = i < 2 ? bg.x : bg.y, xmw = i < 2 ? xm.x : xm.y, cmw = i < 2 ? cm.x : cm.y, xpw = i < 2 ? xp.x : xp.y, cpw = i < 2 ? cp.x : cp.y;
#define HALF16(wd) __builtin_bit_cast(float, (i & 1) ? ((wd) & 0xffff0000u) : ((wd) << 16))
                          const float u1 = HALF16(cgw) * HALF16(xw), u0 = HALF16(cmw) * HALF16(xmw), u2 = HALF16(cpw) * HALF16(xpw);
                          y[i] = HALF16(bgw) * (u0 * cw0[i] + u1 * cw1[i] + u2 * cw2[i] + cb4[i]);
#undef HALF16
                      }
                      *(GAS u32x2*)(YC + (size_t)r * DM + 384 + 4 * lane) = (u32x2){cvtpk(y[0], y[1]), cvtpk(y[2], y[3])}; }
                }
            } else if ((EN & 128) && sp == 7) {
                const GAS bf16* QKVR = (const GAS bf16*)(ws + WS_QKVR); GAS bf16* QM = (GAS bf16*)(ws + WS_QM); GAS bf16* KM = (GAS bf16*)(ws + WS_KM); GAS bf16* VM = (GAS bf16*)(ws + WS_VM);
                const int sub = lane & 15;
                float gs0[8], gs1[8], gs2[8], ik8[8];
                { const float* gqn = ap->in[20] + l * 64; const float* gkn = ap->in[21] + l * 64; const float* gqr = ap->in[22] + l * 32;
#pragma unroll
                  for (int e = 0; e < 8; ++e) {
                      const float gq = sub < 8 ? gqn[8 * sub + e] * QSCALE_M : (sub < 12 ? gqr[8 * (sub - 8) + e] * QSCALE_M : 0.f);
                      const float gk = sub < 8 ? gkn[8 * sub + e] : 0.f;
                      gs0[e] = gq; gs1[e] = lane < 32 ? gq : gk; gs2[e] = gk; ik8[e] = rope_inv32(e); } }
                const float invn_q = sub < 8 ? (1.0f / 64.0f) : (1.0f / 32.0f);
                for (int r = gw; r < MTOT; r += NGW) {
                    const bool lat = r < MLAT; int b, s;
                    if (lat) { b = r >> 11; s = r & 2047; } else { b = (r - MLAT) >> 8; s = (r - MLAT) & 255; }
                    const int pos = lat ? CTXL + s : s;
                    const float posv = sub < 10 ? (float)(s >> 6) : (float)(s & 63);
                    const GAS bf16* q = QKVR + (size_t)r * 1536 + 8 * lane;
                    const u32x4 d0 = *(const GAS u32x4*)q, d1 = *(const GAS u32x4*)(q + 512), d2 = *(const GAS u32x4*)(q + 1024);
#pragma unroll
                    for (int i = 0; i < 3; ++i) {
                        const u32x4 d = i == 0 ? d0 : (i == 1 ? d1 : d2);
                        const bool isq = i == 0 || (i == 1 && lane < 32);
                        const int head = i == 0 ? (lane >> 4) : (i == 1 ? (lane < 32 ? 4 + (lane >> 4) : (lane >> 4) - 2) : 2 + (lane >> 4));
                        float v[8]; UNPK8(d, v);
                        const bool pad = isq && sub >= 12;
                        float ss = 0.f;
#pragma unroll
                        for (int e = 0; e < 8; ++e) { v[e] = pad ? 0.f : v[e]; ss += v[e] * v[e]; }
                        ss += dpp_x1(ss); ss += dpp_x2(ss); ss += dpp_hm(ss);
                        const float rs = rsqrtf(ss * (isq ? invn_q : (1.0f / 64.0f)) + EPS);
#pragma unroll
                        for (int e = 0; e < 8; ++e) v[e] = v[e] * rs * (i == 0 ? gs0[e] : (i == 1 ? gs1[e] : gs2[e]));
                        if (i < 2 && lat) {
                            const bool rp = isq && sub >= 8 && sub < 12;
#pragma unroll
                            for (int e = 0; e < 8; ++e) { const float ang = posv * ik8[e], c = __cosf(ang), sn = __sinf(ang); const float yp = dpp_x1(v[e]);
                                const float rot = (sub & 1) ? v[e] * c + yp * sn : v[e] * c - yp * sn; v[e] = rp ? rot : v[e]; }
                        }
                        const size_t tok = (size_t)(b * 6 + head) * LKV + pos;
                        if (isq) { if (!pad) *(GAS u32x4*)(QM + tok * 96 + (sub < 8 ? 8 * sub : 64 + 8 * (sub - 8))) = PK8(v); }
                        else if (sub < 8) *(GAS u32x4*)(KM + tok * 96 + 8 * sub) = PK8(v);
                        else *(GAS u32x4*)(VM + tok * 64 + 8 * (sub - 8)) = d;
                    }
                }
#undef UNPK8
#undef PK8
            } else if ((EN & 256) && sp == 8) {
                const int vcu = (G % 8 == 0) ? (bx % 8) * (G / 8) + bx / 8 : bx;
                const int nh = (768 - vcu + G - 1) / G;
                for (int k = 0; k < nh + 1; ++k) {
                    int kind, bh, j;
                    if (k < nh) { const int u = vcu + k * G; kind = u < 384 ? 1 : 0; const int rem = u % 384; bh = rem >> 3; j = 1 + (rem & 7); }
                    else { const int u2 = G - 1 - vcu; if (last || u2 >= 96 || u2 < 0) break; kind = u2 < 48 ? 1 : 0; bh = u2 % 48; j = 0; }
                    const int b = bh / 6, h = bh % 6, nk = j == 0 ? CTXL : LKV;
                    if (kind) attn_unit<96>(ldsl, (const GAS bf16*)(ws + WS_QM) + (size_t)bh * LKV * 96, (const GAS bf16*)(ws + WS_KM) + (size_t)bh * LKV * 96, (const GAS bf16*)(ws + WS_VM) + (size_t)bh * LKV * 64,
                                            (GAS bf16*)(ws + WS_YC) + 640 + h * 64, b, j, nk, tid, lane, wave);
                    else attn_unit<64>(ldsl, (const GAS bf16*)(ws + WS_QA) + (size_t)bh * LKV * 64, (const GAS bf16*)(ws + WS_KA) + (size_t)(b * 2 + h / 3) * LKV * 64, (const GAS bf16*)(ws + WS_VA) + (size_t)(b * 2 + h / 3) * LKV * 64,
                                       (GAS bf16*)(ws + WS_YC) + h * 64, b, j, nk, tid, lane, wave);
                }
            } else if ((EN & 4) && (sp == 1 || sp == 11)) {
                const int lj = l * 2 + (sp == 11 ? 1 : 0); const int M = (sp == 11 && last) ? MLAT : MTOT;
                pg8::Gemm g{(const bf16*)(ws + WS_H), (const bf16*)(ws + WS_WGU + lj * SZ_WGU), M, NGU, DM}; pg8::StaticOrder S; S.init(M, NGU, G, bx, DM);
                pg8::EpiSwiGLU E{(bf16*)(ws + WS_GU)};
                pg8::gemm_phase<pg8::EpiSwiGLU, pg8::StaticOrder, true, true>(ldsl, g, S, E, tid);
                if (l + 1 < DEPTH) {
                    const int nfull = S.nwg / G, nbusy = S.nwg - nfull * G;
                    if (bx >= nbusy && nbusy > 0) {
                        __syncthreads();
                        int lane2 = __lane_id(); asm volatile("" : "+v"(lane2));
                        LAS float* scr = (LAS float*)((LAS unsigned char*)lds + wave * 16640);
                        const int half = (I_L + 1) / 2, first = sp == 1 ? 0 : half, lastit = sp == 1 ? half : I_L, nw = (G - nbusy) * 8;
                        for (int it = first + (bx - nbusy) * 8 + wave; it < lastit; it += nw) convert_item(ap, ws, l + 1, it, scr, lane2);
                    }
                }
            } else if ((EN & 8) && (sp == 2 || sp == 12 || sp == 9)) {
                const int lj = l * 2 + (sp == 12 ? 1 : 0); const int M = (sp != 2 && last) ? MLAT : MTOT;
                bf16* Xp = (bf16*)(ws + WS_X);
                pg8::Gemm g{uptr((const bf16*)(ws + (sp == 9 ? WS_YC : WS_GU))), uptr((const bf16*)(sp == 9 ? ws + WS_WOUT + l * SZ_WOUT : ws + WS_WD + lj * SZ_WD)), M, DM, __builtin_amdgcn_readfirstlane(sp == 9 ? DM : DFF)};
                const int Kd = __builtin_amdgcn_readfirstlane(sp == 9 ? DM : DFF);
                pg8::LatCtxOrder S; S.init(M, G, bx, Kd, SPLITS);
                pg8::EpiResid E{uptr(Xp), uptr(Xp), uptr((sp == 12 && last) ? ap->out : (float*)nullptr), uptr(modl), __builtin_amdgcn_readfirstlane(sp == 2 ? 2 : (sp == 9 ? 5 : 8)), __builtin_bit_cast(float, __builtin_amdgcn_readfirstlane(sp == 9 ? 0x3f800000 : 0x3f000000))};
                pg8::gemm_phase<pg8::EpiResid, pg8::LatCtxOrder, true, true>(ldsl, g, S, E, tid);
            } else if ((EN & 16) && (sp == 4 || sp == 6)) {
                const bf16* A; const bf16* Bt; bf16* O; int N, K;
                if (sp == 4) { A = (const bf16*)(ws + WS_H); Bt = (const bf16*)(ws + WS_WIN + l * SZ_WIN); O = (bf16*)(ws + WS_P); N = INP; K = DM; }
                else { A = (const bf16*)(ws + WS_CQKV); Bt = (const bf16*)(ws + WS_WUP + l * SZ_WUP); O = (bf16*)(ws + WS_QKVR); N = 1536; K = 640; }
                pg8::Gemm g{uptr(A), uptr(Bt), MTOT, __builtin_amdgcn_readfirstlane(N), __builtin_amdgcn_readfirstlane(K)}; pg8::BdOrder S; S.init(MTOT, N, G, bx, K, sp == 6);
                pg8::EpiBf16<0> E{uptr(O), __builtin_amdgcn_readfirstlane(N), nullptr, 0, 0, 1.f};
                pg8::gemm_phase<pg8::EpiBf16<0>, pg8::BdOrder, true, true>(ldsl, g, S, E, tid);
            }
        }
        if (ph + 1 < ph_hi) { if (ph_hi < 0) grid.sync(); else xcd_barrier(xbar); }
#if DBL
        { const int bit = ph == 0 ? 13 : (ph - 1) % 13;
          if (!redo && ((DBL >> bit) & 1)) { redo = true; --ph; } else redo = false; }
#endif
    }
}

extern "C" void kernel_launch(void* const* d_in, const int* in_sizes, int n_in, void* d_out, int out_size, void* d_ws, size_t ws_size, hipStream_t stream) {
    static int grid_blocks = 0;
    if (grid_blocks == 0) {
        if (n_in != 24 || out_size != MLAT * DM || ws_size < WS_END) { fprintf(stderr, "kernel_launch: unexpected problem (n_in %d out %d ws %zu need %zu)\n", n_in, out_size, ws_size, (size_t)WS_END); grid_blocks = -1; return; }
        int dev = 0, cus = 0, per_cu = 0;
        (void)hipGetDevice(&dev);
        (void)hipDeviceGetAttribute(&cus, hipDeviceAttributeMultiprocessorCount, dev);
        (void)hipFuncSetAttribute((const void*)fwd_mega, hipFuncAttributeMaxDynamicSharedMemorySize, LDS_BYTES);
        (void)hipOccupancyMaxActiveBlocksPerMultiprocessor(&per_cu, (const void*)fwd_mega, 512, LDS_BYTES);
        if (per_cu < 1) per_cu = 1;
        grid_blocks = cus * per_cu;
        fprintf(stderr, "kernel_launch: grid %d (cus %d x %d), ws %zu need %zu\n", grid_blocks, cus, per_cu, ws_size, (size_t)WS_END);
    }
    if (grid_blocks < 0) return;
    if (hipMemsetAsync((char*)d_ws + WS_CTL, 0, CTL_BYTES, stream) != hipSuccess) { fprintf(stderr, "kernel_launch: memset of the barrier words failed\n"); return; }
    Args a{};
    for (int i = 0; i < 24; ++i) a.in[i] = (const float*)d_in[i];
    a.out = (float*)d_out; a.ws = (unsigned char*)d_ws;
#if MK_MULTI
    for (int ph = 0; ph < NPHASE; ++ph) {
        a.ph_lo = ph; a.ph_hi = ph + 1;
        void* kargs[] = {&a};
        hipError_t e = hipLaunchCooperativeKernel((const void*)fwd_mega, dim3(grid_blocks), dim3(512), kargs, LDS_BYTES, stream);
        if (e != hipSuccess) { fprintf(stderr, "kernel_launch: cooperative launch failed: %s\n", hipGetErrorString(e)); break; }
    }
#else
    a.ph_lo = 0; a.ph_hi = NPHASE;
    void* kargs[] = {&a};
    hipError_t e = hipLaunchCooperativeKernel((const void*)fwd_mega, dim3(grid_blocks), dim3(512), kargs, LDS_BYTES, stream);
    if (e != hipSuccess) fprintf(stderr, "kernel_launch: cooperative launch failed: %s\n", hipGetErrorString(e));
#endif
}
```

```cpp
#include <hip/hip_runtime.h>
#include <hip/hip_cooperative_groups.h>
#include <cstdio>
#include <cstdint>
namespace cg = cooperative_groups;
namespace pg8 {
#define PG8_LAS __attribute__((address_space(3)))
typedef unsigned short bf16_t;
typedef short bf16x8 __attribute__((ext_vector_type(8)));
typedef float f32x4 __attribute__((ext_vector_type(4)));
typedef unsigned u32x4 __attribute__((ext_vector_type(4)));
constexpr int BM = 256, BK = 64, HALF = 128, HTB = HALF * BK * 2  , STAGE_BYTES = 8 * HTB, NXCD = 8, WGM = 8;

__host__ __device__ __forceinline__ int lds_byte(int r, int c) { const int st = (r >> 4) * 2 + (c >> 5), rr = r & 15, cc = c & 31, ob = rr * 64 + cc * 2; return st * 1024 + (ob ^ (((ob >> 9) & 1) << 5)); }
__host__ __device__ __forceinline__ void stage_rc(int b, int& R, int& C) { const int st = b / 1024, sb = b % 1024, swz = sb ^ (((sb >> 9) & 1) << 5); R = (st >> 1) * 16 + swz / 64; C = (st & 1) * 32 + (swz % 64) / 2; }
__host__ __device__ __forceinline__ int perm32(int rho) { const int n = rho >> 4, i = rho & 15; return 8 * (i >> 2) + 4 * n + (i & 3); }

struct Unit { int pm, pn, kt0, ntk, part; };
struct Gemm { const bf16_t* A; const bf16_t* Bt; int M, N, K; };

struct StaticOrder {
    int nM, nN, nwg, G, c, ntk;
    __host__ __device__ void init(int M, int N, int G_, int c_, int K_) { nM = M / BM; nN = N / BM; nwg = nM * nN; G = G_; c = c_; ntk = K_ / BK; }
    __host__ __device__ bool next(int i, Unit& u) const {
        const long L = (long)i * G + c; if (L >= nwg) return false;
        int wgid = (int)L; { const int q = nwg / NXCD, r = nwg % NXCD, xcd = wgid % NXCD, off = wgid / NXCD; wgid = (xcd < r ? xcd * (q + 1) : r * (q + 1) + (xcd - r) * q) + off; }
        const int nig = WGM * nN, gid = wgid / nig, fm = gid * WGM, gsz = (nM - fm) < WGM ? (nM - fm) : WGM;
        u.pm = fm + ((wgid % nig) % gsz); u.pn = (wgid % nig) / gsz; u.kt0 = 0; u.ntk = ntk; u.part = 0; return true;
    }
    __device__ __forceinline__ void a_ready(const Unit&) const {}
    __device__ __forceinline__ void done(const Unit&) const {}
};

__device__ __forceinline__ unsigned cvt_pk_bf16(float lo, float hi) { unsigned r; asm volatile("v_cvt_pk_bf16_f32 %0, %1, %2" : "=v"(r) : "v"(lo), "v"(hi)); return r; }
typedef float f32x2 __attribute__((ext_vector_type(2)));
template <int ACT  > struct EpiBf16 {
    static constexpr bool PERM = true, AFTER_DRAIN = false; static_assert(ACT == 0, "EpiBf16: ACT is 0");
    bf16_t* O; int ldc; const float* bias; int split_cols; size_t split_stride; float scale0;
    __device__ __forceinline__ void operator()(const f32x4 (&acc)[2][2][4][2], const Unit& u, int wr, int wc, int fr, int fq) const {
        const int row0 = u.pm * BM + wr * 64 + fr; int colt = u.pn * BM; bf16_t* base = O;
        float sc = 1.f; if (split_cols) { const int t = colt / split_cols; base += (size_t)t * split_stride; colt -= t * split_cols; if (t == 0) sc = scale0; }
        const int col0 = colt + wc * 32 + 8 * fq, bcol0 = u.pn * BM + wc * 32 + 8 * fq;
        f32x4 bv[2][2];
#pragma unroll
        for (int bj = 0; bj < 2; ++bj)
#pragma unroll
            for (int n = 0; n < 2; ++n) bv[bj][n] = bias ? *(const f32x4*)(bias + bcol0 + bj * HALF + 4 * n) : (f32x4){0.f, 0.f, 0.f, 0.f};
#pragma unroll
        for (int ai = 0; ai < 2; ++ai)
#pragma unroll
            for (int m = 0; m < 4; ++m) { bf16_t* rowp = base + (size_t)(row0 + ai * HALF + m * 16) * ldc + col0;
#pragma unroll
                for (int bj = 0; bj < 2; ++bj) { f32x4 v0 = acc[ai][bj][m][0] + bv[bj][0], v1 = acc[ai][bj][m][1] + bv[bj][1];
                    v0 = v0 * sc; v1 = v1 * sc; u32x4 w; w.x = cvt_pk_bf16(v0[0], v0[1]); w.y = cvt_pk_bf16(v0[2], v0[3]); w.z = cvt_pk_bf16(v1[0], v1[1]); w.w = cvt_pk_bf16(v1[2], v1[3]);
                    if (!(ldc == 2304 && col0 + bj * HALF >= 2080) && !(ldc == 1536 && u.pn < 3 && wc == 3)) *(u32x4*)(rowp + bj * HALF) = w; } }
    }
};
template <class Epi, class Sched, bool ALIGN_EPI = false, bool SP2 = false>
__device__ __forceinline__ void gemm_phase(PG8_LAS unsigned char* lds, const Gemm g, const Sched& S, const Epi& E, int tid_) {
    asm volatile("" : "+v"(tid_));
    const int tid = tid_, wid = __builtin_amdgcn_readfirstlane(tid >> 6), lane = tid & 63, wr = wid >> 2, wc = wid & 3, fr = lane & 15, fq = lane >> 4;
    const int K = g.K; int nt;
    unsigned voffA[2], voffB[2];
#pragma unroll
    for (int i = 0; i < 2; ++i) { int R, C; stage_rc(tid * 16 + i * 8192, R, C); const int Rb = Epi::PERM ? ((R & ~31) + perm32(R & 31)) : R;
        voffA[i] = (unsigned)(R * K + C) * 2u; voffB[i] = (unsigned)(Rb * K + C) * 2u; }
    const size_t kstep = (size_t)(BK * 2);
    const size_t hstep = (size_t)HALF * K * 2;
    const size_t tstep = 2 * hstep;
    const unsigned ldsw = (unsigned)wid * 1024u;
    const int aoff = lds_byte(wr * 64 + fr, fq * 8), boff = lds_byte(wc * 32 + fr, fq * 8);
#define PG8_SA(b, h) (((b) * 2 + (h)) * HTB)
#define PG8_SB(b, h) ((4 + (b) * 2 + (h)) * HTB)
#define PG8_STAGE(bufoff, gbase, voff) do { _Pragma("unroll") for (int _i = 0; _i < 2; ++_i) \
        __builtin_amdgcn_global_load_lds((const unsigned*)((const char*)(gbase) + (voff)[_i]), (PG8_LAS unsigned*)(lds + (bufoff) + ldsw + _i * 8192), 16, 0, 0); } while (0)
#define PG8_LDA(dst, b, h) do { _Pragma("unroll") for (int m = 0; m < 4; ++m) _Pragma("unroll") for (int k = 0; k < 2; ++k) dst[m][k] = *(const PG8_LAS bf16x8*)(lds + PG8_SA(b, h) + aoff + m * 2048 + k * 1024); } while (0)
#define PG8_LDB(dst, b, h) do { _Pragma("unroll") for (int n = 0; n < 2; ++n) _Pragma("unroll") for (int k = 0; k < 2; ++k) dst[n][k] = *(const PG8_LAS bf16x8*)(lds + PG8_SB(b, h) + boff + n * 2048 + k * 1024); } while (0)
#define PG8_MMA(ai, bj, At, Bt) do { __builtin_amdgcn_s_setprio(1); _Pragma("unroll") for (int m = 0; m < 4; ++m) _Pragma("unroll") for (int n = 0; n < 2; ++n) _Pragma("unroll") for (int k = 0; k < 2; ++k) \
        acc[ai][bj][m][n] = __builtin_amdgcn_mfma_f32_16x16x32_bf16(Bt[n][k], At[m][k], acc[ai][bj][m][n], 0, 0, 0); __builtin_amdgcn_s_setprio(0); } while (0)
#define PG8_WAIT_V(n) asm volatile("s_waitcnt vmcnt(" #n ")" ::: "memory")
#define PG8_WAIT_L(n) asm volatile("s_waitcnt lgkmcnt(" #n ")" ::: "memory")
#define PG8_BAR __builtin_amdgcn_s_barrier()
#define PG8_SCHED __builtin_amdgcn_sched_barrier(0)
    Unit cur, nxt; int ui = 0;
    if (!S.next(0, cur)) return;
    f32x4 acc[2][2][4][2];
#pragma unroll
    for (int a = 0; a < 2; ++a)
#pragma unroll
        for (int b = 0; b < 2; ++b)
#pragma unroll
            for (int m = 0; m < 4; ++m)
#pragma unroll
                for (int n = 0; n < 2; ++n) acc[a][b][m][n] = (f32x4){0.f, 0.f, 0.f, 0.f};
    bf16x8 At[4][2], B0[2][2], B1[2][2];
    const char* cA = (const char*)g.A + (size_t)cur.pm * tstep + (size_t)cur.kt0 * kstep; const char* cB = (const char*)g.Bt + (size_t)cur.pn * tstep + (size_t)cur.kt0 * kstep; nt = cur.ntk;
    S.a_ready(cur);
    if constexpr (SP2) {
        PG8_STAGE(PG8_SB(0, 0), cB, voffB); PG8_STAGE(PG8_SB(0, 1), cB + hstep, voffB); PG8_STAGE(PG8_SA(0, 0), cA, voffA); PG8_STAGE(PG8_SA(0, 1), cA + hstep, voffA);
        if (wr == 1) PG8_BAR;
        PG8_WAIT_V(2); PG8_BAR;
        PG8_STAGE(PG8_SB(1, 0), cB + kstep, voffB); PG8_STAGE(PG8_SA(1, 0), cA + kstep, voffA); PG8_STAGE(PG8_SB(1, 1), cB + hstep + kstep, voffB);
        PG8_WAIT_V(6); PG8_BAR;
    } else {
        PG8_STAGE(PG8_SB(0, 0), cB, voffB); PG8_STAGE(PG8_SA(0, 0), cA, voffA); PG8_STAGE(PG8_SB(0, 1), cB + hstep, voffB); PG8_STAGE(PG8_SA(0, 1), cA + hstep, voffA);
        if (wr == 1) PG8_BAR;
        PG8_WAIT_V(4); PG8_BAR;
        PG8_STAGE(PG8_SB(1, 0), cB + kstep, voffB); PG8_STAGE(PG8_SA(1, 0), cA + kstep, voffA); PG8_STAGE(PG8_SB(1, 1), cB + hstep + kstep, voffB);
        PG8_WAIT_V(6); PG8_BAR;
    }
    for (;;) {
        const bool has_next = S.next(ui + 1, nxt);
        const char* nA = has_next ? (const char*)g.A + (size_t)nxt.pm * tstep + (size_t)nxt.kt0 * kstep : cA; const char* nB = has_next ? (const char*)g.Bt + (size_t)nxt.pn * tstep + (size_t)nxt.kt0 * kstep : cB;
        for (int t = 0; t < nt; t += 2) {
            const bool last = (t == nt - 2);
            const char* a1 = cA + (size_t)(t + 1) * kstep;
            const char* a2 = last ? nA : cA + (size_t)(t + 2) * kstep; const char* b2 = last ? nB : cB + (size_t)(t + 2) * kstep;
            const char* a3 = a2 + kstep; const char* b3 = b2 + kstep;
            if (last && has_next) S.a_ready(nxt);
            if constexpr (SP2) {
            PG8_LDB(B0, 0, 0); PG8_LDB(B1, 0, 1); PG8_SCHED; PG8_LDA(At, 0, 0); PG8_STAGE(PG8_SA(1, 1), a1 + hstep, voffA);
            PG8_WAIT_V(8); PG8_WAIT_L(0); PG8_BAR; PG8_MMA(0, 0, At, B0); PG8_MMA(0, 1, At, B1); PG8_BAR; PG8_SCHED;
            PG8_LDA(At, 0, 1); PG8_STAGE(PG8_SB(0, 0), b2, voffB); PG8_STAGE(PG8_SB(0, 1), b2 + hstep, voffB); PG8_STAGE(PG8_SA(0, 0), a2, voffA);
            PG8_WAIT_V(8); PG8_WAIT_L(0); PG8_BAR; PG8_MMA(1, 0, At, B0); PG8_MMA(1, 1, At, B1); PG8_BAR; PG8_SCHED;
            PG8_LDB(B0, 1, 0); PG8_LDB(B1, 1, 1); PG8_SCHED; PG8_LDA(At, 1, 0); PG8_STAGE(PG8_SA(0, 1), a2 + hstep, voffA);
            PG8_WAIT_V(8); PG8_WAIT_L(0); PG8_BAR; PG8_MMA(0, 0, At, B0); PG8_MMA(0, 1, At, B1); PG8_BAR; PG8_SCHED;
            PG8_LDA(At, 1, 1); PG8_STAGE(PG8_SB(1, 0), b3, voffB); PG8_STAGE(PG8_SB(1, 1), b3 + hstep, voffB); PG8_STAGE(PG8_SA(1, 0), a3, voffA);
            PG8_WAIT_V(8); PG8_WAIT_L(0); PG8_BAR; PG8_MMA(1, 0, At, B0); PG8_MMA(1, 1, At, B1); PG8_BAR; PG8_SCHED;
            } else {
            PG8_LDB(B0, 0, 0); PG8_SCHED; PG8_LDA(At, 0, 0); PG8_STAGE(PG8_SA(1, 1), a1 + hstep, voffA);
            PG8_WAIT_L(8); PG8_BAR; PG8_WAIT_L(0); PG8_MMA(0, 0, At, B0); PG8_BAR; PG8_SCHED;
            PG8_LDB(B1, 0, 1); PG8_STAGE(PG8_SB(0, 0), b2, voffB);
            PG8_BAR; PG8_WAIT_L(0); PG8_MMA(0, 1, At, B1); PG8_BAR;
            PG8_LDA(At, 0, 1); PG8_STAGE(PG8_SA(0, 0), a2, voffA);
            PG8_BAR; PG8_WAIT_L(0); PG8_MMA(1, 0, At, B0); PG8_BAR; PG8_SCHED;
            PG8_STAGE(PG8_SB(0, 1), b2 + hstep, voffB);
            PG8_WAIT_V(6); PG8_BAR; PG8_MMA(1, 1, At, B1); PG8_BAR;
            PG8_LDB(B0, 1, 0); PG8_SCHED; PG8_LDA(At, 1, 0); PG8_STAGE(PG8_SA(0, 1), a2 + hstep, voffA);
            PG8_WAIT_L(8); PG8_BAR; PG8_WAIT_L(0); PG8_MMA(0, 0, At, B0); PG8_BAR; PG8_SCHED;
            PG8_LDB(B1, 1, 1); PG8_STAGE(PG8_SB(1, 0), b3, voffB);
            PG8_BAR; PG8_WAIT_L(0); PG8_MMA(0, 1, At, B1); PG8_BAR;
            PG8_LDA(At, 1, 1); PG8_STAGE(PG8_SA(1, 0), a3, voffA);
            PG8_BAR; PG8_WAIT_L(0); PG8_MMA(1, 0, At, B0); PG8_BAR; PG8_SCHED;
            PG8_STAGE(PG8_SB(1, 1), b3 + hstep, voffB);
            PG8_WAIT_V(6); PG8_BAR; PG8_MMA(1, 1, At, B1); PG8_BAR;
            }
        }
        if constexpr (ALIGN_EPI) { if (wr == 0) PG8_BAR; }
        if constexpr (!Epi::AFTER_DRAIN) { E(acc, cur, wr, wc, fr, fq); S.done(cur); }
        if (!has_next) break;
#pragma unroll
        for (int a = 0; a < 2; ++a)
#pragma unroll
            for (int b = 0; b < 2; ++b)
#pragma unroll
                for (int m = 0; m < 4; ++m)
#pragma unroll
                    for (int n = 0; n < 2; ++n) acc[a][b][m][n] = (f32x4){0.f, 0.f, 0.f, 0.f};
        cur = nxt; cA = nA; cB = nB; nt = cur.ntk; ++ui;
        if constexpr (ALIGN_EPI) { if (wr == 1) PG8_BAR; }
    }
    PG8_WAIT_V(0);
    if constexpr (!ALIGN_EPI) { if (wr == 0) PG8_BAR; }
    PG8_BAR;
    if constexpr (Epi::AFTER_DRAIN) { E.fused(acc, cur, wr, wc, fr, fq, lds, wid, lane); S.done(cur); }
#undef PG8_SA
#undef PG8_SB
#undef PG8_STAGE
#undef PG8_LDA
#undef PG8_LDB
#undef PG8_MMA
#undef PG8_WAIT_V
#undef PG8_WAIT_L
#undef PG8_BAR
#undef PG8_SCHED
}
}

#ifndef MK_MULTI
#define MK_MULTI 0
#endif
#ifndef DBL
#define DBL 0
#endif
#ifndef EN
#define EN 0xffff
#endif
#define LAS __attribute__((address_space(3)))
#define GAS __attribute__((address_space(1)))
typedef unsigned short bf16;
typedef float f32x4 __attribute__((ext_vector_type(4)));
typedef unsigned u32x4 __attribute__((ext_vector_type(4)));
typedef unsigned u32x2 __attribute__((ext_vector_type(2)));

constexpr int DM = 1024, NB = 8, SEQ = 2048, DEPTH = 4, CTXL = 256, DFF = 2816, NMOD = 9;
constexpr int MLAT = NB * SEQ, MCTX = NB * CTXL, MTOT = MLAT + MCTX;
constexpr int LKV = CTXL + SEQ;
constexpr int INC = 2080, INP = 2304;
constexpr int PC_K = 384, PC_V = 512, PC_X = 640, PC_BG = 896, PC_CG = 1152, PC_CQ = 1408, PC_CKV = 1792, PC_KR = 2048;
constexpr int NGU = 2 * DFF;
constexpr float EPS = 1e-6f;
constexpr float LOG2E = 1.4426950408889634f;
constexpr float QSCALE_A = 0.125f * LOG2E;
constexpr float QSCALE_M = 0.10206207261596577f * LOG2E;
constexpr float L2THETA = 13.287712379549449f;

constexpr size_t MiB = 1u << 20;
constexpr size_t WS_MOD = 0;
constexpr size_t WS_CTL = 1536 * 1024, CTL_BYTES = 16384;
constexpr size_t WS_WGU = 2 * MiB;
constexpr size_t SZ_WGU = (size_t)NGU * DM * 2;
constexpr size_t WS_WD = WS_WGU + 8 * SZ_WGU;
constexpr size_t SZ_WD = (size_t)DM * DFF * 2;
constexpr size_t WS_WIN = WS_WD + 8 * SZ_WD;
constexpr size_t SZ_WIN = (size_t)INP * DM * 2;
constexpr size_t WS_WOUT = WS_WIN + 4 * SZ_WIN;
constexpr size_t SZ_WOUT = (size_t)DM * DM * 2;
constexpr size_t WS_WUP = WS_WOUT + 4 * SZ_WOUT;
constexpr size_t SZ_WUP = (size_t)1536 * 640 * 2;
constexpr size_t WS_X = WS_WUP + 4 * SZ_WUP;
constexpr size_t WS_H = WS_X + (size_t)MTOT * DM * 4;
constexpr size_t WS_R = WS_H + (size_t)MTOT * DM * 2;
constexpr size_t WS_GU = WS_R;
constexpr size_t WS_P = WS_R;
constexpr size_t WS_QKVR = WS_R;
constexpr size_t WS_CQKV = WS_P + (size_t)MTOT * INP * 2;
constexpr size_t WS_QA = WS_CQKV + (size_t)MTOT * 640 * 2;
constexpr size_t WS_PART = WS_QA;
constexpr size_t WS_KA = WS_QA + (size_t)NB * 6 * LKV * 64 * 2;
constexpr size_t WS_VA = WS_KA + (size_t)NB * 2 * LKV * 64 * 2;
constexpr size_t WS_QM = WS_VA + (size_t)NB * 2 * LKV * 64 * 2;
constexpr size_t WS_KM = WS_QM + (size_t)NB * 6 * LKV * 96 * 2;
constexpr size_t WS_VM = WS_KM + (size_t)NB * 6 * LKV * 96 * 2;
constexpr size_t WS_YC = WS_VM + (size_t)NB * 6 * LKV * 64 * 2;
constexpr size_t WS_END = WS_YC + (size_t)MTOT * DM * 2;
static_assert(WS_QKVR + (size_t)MTOT * 1536 * 2 <= WS_CQKV, "QKVR overlays P");
static_assert(WS_GU + (size_t)MTOT * DFF * 2 <= WS_END, "GU inside the shared region");
static_assert(WS_X % 256 == 0 && WS_R % 256 == 0 && WS_QA % 256 == 0 && WS_YC % 256 == 0, "alignment");

#ifndef SPLITS
#define SPLITS 4
#endif
static_assert(WS_PART >= WS_GU + (size_t)MTOT * DFF * 2 && WS_PART + (size_t)SPLITS * MCTX * DM * 4 <= WS_YC, "split-K parts overlay QA..VM (all dead while the parts are live), clear of GU and YC");
constexpr int LDS_BYTES = 147456;
constexpr int NPHASE = 1 + 13 * DEPTH;

__device__ __forceinline__ float shx(float v, int o, int lane) { return __builtin_bit_cast(float, __builtin_amdgcn_ds_bpermute((lane ^ o) << 2, __builtin_bit_cast(int, v))); }
__device__ __forceinline__ float dpp_x1(float v) { return __builtin_bit_cast(float, __builtin_amdgcn_update_dpp(0, __builtin_bit_cast(int, v), 0xB1, 0xF, 0xF, false)); }
__device__ __forceinline__ float dpp_x2(float v) { return __builtin_bit_cast(float, __builtin_amdgcn_update_dpp(0, __builtin_bit_cast(int, v), 0x4E, 0xF, 0xF, false)); }
__device__ __forceinline__ float dpp_hm(float v) { return __builtin_bit_cast(float, __builtin_amdgcn_update_dpp(0, __builtin_bit_cast(int, v), 0x141, 0xF, 0xF, false)); }
__device__ __forceinline__ float wave_sum(float v, int lane) {
#pragma unroll
    for (int o = 1; o < 64; o <<= 1) v += shx(v, o, lane);
    return v;
}
__device__ __forceinline__ float wave_max(float v, int lane) {
#pragma unroll
    for (int o = 1; o < 64; o <<= 1) v = fmaxf(v, shx(v, o, lane));
    return v;
}
__device__ __forceinline__ unsigned f2bf(float f) { unsigned u = __builtin_bit_cast(unsigned, f); return (u + 0x7fffu + ((u >> 16) & 1u)) >> 16; }
__device__ __forceinline__ unsigned pk2(float lo, float hi) { return f2bf(lo) | (f2bf(hi) << 16); }
__device__ __forceinline__ float bf2f(bf16 b) { return __builtin_bit_cast(float, (unsigned)b << 16); }
__device__ __forceinline__ float silu_f(float g) { return g * __builtin_amdgcn_rcpf(1.0f + __expf(-g)); }

template <class T> __device__ __forceinline__ T* uptr(T* p) {
    unsigned long long v = (unsigned long long)p;
    const unsigned lo = __builtin_amdgcn_readfirstlane((unsigned)v), hi = __builtin_amdgcn_readfirstlane((unsigned)(v >> 32));
    return (T*)(((unsigned long long)hi << 32) | lo);
}
namespace pg8 {
struct EpiSwiGLU {
    static constexpr bool PERM = true, AFTER_DRAIN = false;
    bf16_t* O;
    __device__ __forceinline__ void operator()(const f32x4 (&acc)[2][2][4][2], const Unit& u, int wr, int wc, int fr, int fq) const {
        const int row0 = u.pm * BM + wr * 64 + fr, col0 = u.pn * HALF + wc * 32 + 8 * fq;
#pragma unroll
        for (int ai = 0; ai < 2; ++ai)
#pragma unroll
            for (int m = 0; m < 4; ++m) {
                bf16_t* rowp = O + (size_t)(row0 + ai * HALF + m * 16) * DFF + col0;
                const f32x4 g0 = acc[ai][0][m][0], g1 = acc[ai][0][m][1], u0 = acc[ai][1][m][0], u1 = acc[ai][1][m][1];
                u32x4 w;
                w.x = cvt_pk_bf16(silu_f(g0[0]) * u0[0], silu_f(g0[1]) * u0[1]);
                w.y = cvt_pk_bf16(silu_f(g0[2]) * u0[2], silu_f(g0[3]) * u0[3]);
                w.z = cvt_pk_bf16(silu_f(g1[0]) * u1[0], silu_f(g1[1]) * u1[1]);
                w.w = cvt_pk_bf16(silu_f(g1[2]) * u1[2], silu_f(g1[3]) * u1[3]);
                *(u32x4*)rowp = w;
            }
    }
};
struct EpiResid {
    static constexpr bool PERM = true, AFTER_DRAIN = false;
    const bf16_t* xin; bf16_t* xout; float* fout; const float* modl; int kmod; float coef;
    __device__ __forceinline__ void operator()(const f32x4 (&acc)[2][2][4][2], const Unit& u, int wr, int wc, int fr, int fq) const {
        const int rowt = u.pm * BM; const int mr = rowt < MLAT ? (rowt >> 11) : 8;
        const float* gv = modl + (size_t)mr * (NMOD * DM) + kmod * DM;
        const int col0 = u.pn * BM + wc * 32 + 8 * fq;
        f32x4 g[2][2];
#pragma unroll
        for (int bj = 0; bj < 2; ++bj)
#pragma unroll
            for (int n = 0; n < 2; ++n) g[bj][n] = *(const f32x4*)(gv + col0 + bj * HALF + 4 * n) * coef;
        float* part = (float*)((char*)const_cast<bf16_t*>(xin) + ((long long)WS_PART - (long long)WS_X));
        if (u.ntk != (kmod == 5 ? DM / 64 : DFF / 64)) {
#pragma unroll
            for (int ai = 0; ai < 2; ++ai)
#pragma unroll
                for (int m = 0; m < 4; ++m) {
                    bf16_t* pp = (bf16_t*)part + ((size_t)u.part * MCTX + (rowt - MLAT + ai * HALF + wr * 64 + m * 16 + fr)) * DM + col0;
#pragma unroll
                    for (int bj = 0; bj < 2; ++bj) { const f32x4 y0 = g[bj][0] * acc[ai][bj][m][0], y1 = g[bj][1] * acc[ai][bj][m][1];
                        u32x4 o; o.x = cvt_pk_bf16(y0[0], y0[1]); o.y = cvt_pk_bf16(y0[2], y0[3]); o.z = cvt_pk_bf16(y1[0], y1[1]); o.w = cvt_pk_bf16(y1[2], y1[3]); *(u32x4*)(pp + bj * HALF) = o; }
                }
            return;
        }
#pragma unroll
        for (int ai = 0; ai < 2; ++ai) {
            u32x4 xb[4][2];
#pragma unroll
            for (int m = 0; m < 4; ++m)
#pragma unroll
                for (int bj = 0; bj < 2; ++bj) xb[m][bj] = *(const u32x4*)(xin + (size_t)(rowt + ai * HALF + wr * 64 + m * 16 + fr) * DM + col0 + bj * HALF);
#pragma unroll
            for (int m = 0; m < 4; ++m) {
                const size_t off = (size_t)(rowt + ai * HALF + wr * 64 + m * 16 + fr) * DM + col0;
#pragma unroll
                for (int bj = 0; bj < 2; ++bj) {
                    const u32x4 x = xb[m][bj];
                    const f32x4 x0 = {__builtin_bit_cast(float, x.x << 16), __builtin_bit_cast(float, x.x & 0xffff0000u), __builtin_bit_cast(float, x.y << 16), __builtin_bit_cast(float, x.y & 0xffff0000u)};
                    const f32x4 x1 = {__builtin_bit_cast(float, x.z << 16), __builtin_bit_cast(float, x.z & 0xffff0000u), __builtin_bit_cast(float, x.w << 16), __builtin_bit_cast(float, x.w & 0xffff0000u)};
                    const f32x4 y0 = x0 + g[bj][0] * acc[ai][bj][m][0], y1 = x1 + g[bj][1] * acc[ai][bj][m][1];
                    if (fout) { *(f32x4*)(fout + off + bj * HALF) = y0; *(f32x4*)(fout + off + bj * HALF + 4) = y1; }
                    else { u32x4 o; o.x = cvt_pk_bf16(y0[0], y0[1]); o.y = cvt_pk_bf16(y0[2], y0[3]); o.z = cvt_pk_bf16(y1[0], y1[1]); o.w = cvt_pk_bf16(y1[2], y1[3]); *(u32x4*)(xout + off + bj * HALF) = o; }
                }
            }
            asm volatile("" ::: "memory");
        }
    }
};
struct BdOrder {
    StaticOrder base; bool bd;
    __device__ void init(int M, int N, int G_, int c_, int K_, bool bd_) { base.init(M, N, G_, c_, K_); bd = bd_; }
    __device__ bool next(int i, Unit& u) const {
        if (!base.next(i, u)) return false;
        if (bd) { if (u.pn < 3) { u.kt0 = 0; u.ntk = 6; } else { u.kt0 = 6; u.ntk = 4; } }
        return true;
    }
    __device__ __forceinline__ void a_ready(const Unit&) const {}
    __device__ __forceinline__ void done(const Unit&) const {}
};
struct LatCtxOrder {
    StaticOrder lat, all; int G, c, nlr, nseg, S, npairs; bool plain;
    __device__ void init(int M, int G_, int c_, int K_, int S_) {
        lat.init(MLAT, DM, G_, c_, K_); all.init(M, DM, G_, c_, K_); G = G_; c = c_; S = S_; npairs = K_ / (2 * BK);
        plain = (lat.nwg % G_) != 0 || M <= MLAT; nlr = lat.nwg / G_; nseg = ((M - MLAT) / BM) * 4 * S_;
    }
    __device__ bool next(int i, Unit& u) const {
        if (plain) return all.next(i, u);
        if (i < nlr) return lat.next(i, u);
        const int sidx = (i - nlr) * G + c; if (sidx >= nseg) return false;
        const int tile = sidx / S, part = sidx % S, p0 = part * npairs / S, p1 = (part + 1) * npairs / S;
        u.pm = MLAT / BM + (tile >> 2); u.pn = tile & 3; u.kt0 = 2 * p0; u.ntk = 2 * (p1 - p0); u.part = part; return true;
    }
    __device__ __forceinline__ void a_ready(const Unit&) const {}
    __device__ __forceinline__ void done(const Unit&) const {}
};
}


typedef short bf16x8 __attribute__((ext_vector_type(8)));
typedef short s16x4 __attribute__((ext_vector_type(4)));
typedef float f32x16 __attribute__((ext_vector_type(16)));
__device__ __forceinline__ int crow(int r, int hi) { return (r & 3) + 8 * (r >> 2) + 4 * hi; }
typedef float f32x2_t __attribute__((ext_vector_type(2))); typedef __bf16 bf16x2_t __attribute__((ext_vector_type(2)));
__device__ __forceinline__ unsigned cvtpk(float lo, float hi) { f32x2_t v = {lo, hi}; bf16x2_t b = __builtin_convertvector(v, bf16x2_t); return __builtin_bit_cast(unsigned, b); }
constexpr int AT_KBUF = 26624, AT_VBUF = 16384, AT_VOFF = 2 * AT_KBUF, AT_WSF = AT_VOFF + 2 * AT_VBUF;
template <int DK>
__device__ __forceinline__ void attn_unit(LAS unsigned char* lds, const GAS bf16* Qp, const GAS bf16* Kp, const GAS bf16* Vp, GAS bf16* Yp, int b, int j, int nkeys, int tid, int lane, int wave) {
    constexpr int KSTR = DK * 2 + 16, ND = DK / 16, CPR = DK / 8, NKC = CPR / 4;
    const int r32 = lane & 31, hi = lane >> 5;
    bf16x8 qr[ND];
    { const GAS bf16* Qw = Qp + (size_t)(256 * j + wave * 32 + r32) * DK + hi * 8;
#pragma unroll
      for (int d0 = 0; d0 < ND; ++d0) qr[d0] = *(const GAS bf16x8*)(Qw + d0 * 16); }
    int koff[NKC], voff[2];
#pragma unroll
    for (int i = 0; i < NKC; ++i) { const int kc = tid + 512 * i; koff[i] = (kc / CPR) * KSTR + (kc % CPR) * 16; }
#pragma unroll
    for (int i = 0; i < 2; ++i) { const int vc = tid + 512 * i, vrow = vc >> 3, vch = vc & 7; voff[i] = AT_VOFF + (vch >> 2) * 8192 + (vrow >> 4) * 1024 + (vrow & 15) * 64 + (vch & 3) * 16; }
    const int NT = nkeys >> 7;
    u32x4 kreg[NKC], vreg[2];
#define AT_LOAD(t) do { const GAS u32x4* Kg_ = (const GAS u32x4*)(Kp + (size_t)(t) * 128 * DK); const GAS u32x4* Vg_ = (const GAS u32x4*)(Vp + (size_t)(t) * 128 * 64); \
        _Pragma("unroll") for (int i_ = 0; i_ < NKC; ++i_) kreg[i_] = Kg_[tid + 512 * i_]; vreg[0] = Vg_[tid]; vreg[1] = Vg_[tid + 512]; } while (0)
#define AT_STORE(bf_) do { LAS unsigned char* nb_ = lds + (bf_) * AT_KBUF; _Pragma("unroll") for (int i_ = 0; i_ < NKC; ++i_) *(LAS u32x4*)(nb_ + koff[i_]) = kreg[i_]; \
        *(LAS u32x4*)(lds + (bf_) * AT_VBUF + voff[0]) = vreg[0]; *(LAS u32x4*)(lds + (bf_) * AT_VBUF + voff[1]) = vreg[1]; } while (0)
    AT_LOAD(0); AT_STORE(0);
    if (NT > 1) AT_LOAD(1);
    __syncthreads();
    LAS float* wsf = (LAS float*)(lds + AT_WSF) + wave * 32;
    float mhat = 0.f;
    f32x16 o0, o1, ol, negm;
#pragma unroll
    for (int r = 0; r < 16; ++r) { o0[r] = 0.f; o1[r] = 0.f; ol[r] = 0.f; negm[r] = 0.f; }
    const bf16x8 ones = {0x3F80, 0x3F80, 0x3F80, 0x3F80, 0x3F80, 0x3F80, 0x3F80, 0x3F80};
    const int kfo = r32 * KSTR + hi * 16;
    const int vfo = AT_VOFF + (4 * hi + ((lane & 15) >> 2)) * 64 + ((lane >> 4) & 1) * 32 + (lane & 3) * 8;
    for (int t = 0; t < NT; ++t) {
        const int cur = t & 1;
        f32x16 p[4];
        { LAS unsigned char* kb = lds + cur * AT_KBUF + kfo;
          bf16x8 ka[2][4];
#pragma unroll
          for (int q4 = 0; q4 < 4; ++q4) ka[0][q4] = *(LAS bf16x8*)(kb + q4 * 32 * KSTR);
#pragma unroll
          for (int d0 = 0; d0 < ND; ++d0) {
              if (d0 + 1 < ND) {
#pragma unroll
                  for (int q4 = 0; q4 < 4; ++q4) ka[(d0 + 1) & 1][q4] = *(LAS bf16x8*)(kb + q4 * 32 * KSTR + (d0 + 1) * 32);
              }
#pragma unroll
              for (int q4 = 0; q4 < 4; ++q4) p[q4] = __builtin_amdgcn_mfma_f32_32x32x16_bf16(ka[d0 & 1][q4], qr[d0], d0 == 0 ? negm : p[q4], 0, 0, 0);
              if (d0 == 0) { if (t + 1 < NT) AT_STORE(cur ^ 1); if (t + 2 < NT) AT_LOAD(t + 2); }
              __builtin_amdgcn_sched_barrier(0);
          } }
        float rma = fmaxf(p[0][0], p[1][0]), rmb = fmaxf(p[2][0], p[3][0]);
#pragma unroll
        for (int r = 1; r < 16; ++r) { rma = fmaxf(fmaxf(rma, p[0][r]), p[1][r]); rmb = fmaxf(fmaxf(rmb, p[2][r]), p[3][r]); }
        float rm = fmaxf(rma, rmb);
        { const unsigned ru_ = __builtin_bit_cast(unsigned, rm); auto rr_ = __builtin_amdgcn_permlane32_swap(ru_, ru_, false, false);
          rm = fmaxf(__builtin_bit_cast(float, (unsigned)rr_[0]), __builtin_bit_cast(float, (unsigned)rr_[1])); }
        if (t == 0 || __any(rm > 8.0f)) {
            const float dl = (t == 0) ? rm : fmaxf(rm, 0.f), f = __builtin_amdgcn_exp2f(-dl);
            mhat += dl;
#pragma unroll
            for (int r = 0; r < 16; ++r) { p[0][r] -= dl; p[1][r] -= dl; p[2][r] -= dl; p[3][r] -= dl; negm[r] = -mhat; }
            if (hi == 0) wsf[r32] = f;
            asm volatile("s_waitcnt lgkmcnt(0)" ::: "memory");
#pragma unroll
            for (int r = 0; r < 16; ++r) { const float fr = wsf[crow(r, hi)]; o0[r] *= fr; o1[r] *= fr; ol[r] *= fr; }
            asm volatile("s_waitcnt lgkmcnt(0)" ::: "memory");
        }
        u32x4 pw[8];
        { LAS unsigned char* vb = lds + cur * AT_VBUF + vfo;
#define AT_VF(d0, ks) ({ const s16x4 lo_ = __builtin_bit_cast(s16x4, __builtin_amdgcn_ds_read_tr16_b64_v4i16((LAS s16x4*)(vb + (d0) * 8192 + (ks) * 1024))); \
                         const s16x4 hi_ = __builtin_bit_cast(s16x4, __builtin_amdgcn_ds_read_tr16_b64_v4i16((LAS s16x4*)(vb + (d0) * 8192 + (ks) * 1024 + 512))); \
                         (bf16x8){lo_[0], lo_[1], lo_[2], lo_[3], hi_[0], hi_[1], hi_[2], hi_[3]}; })
#define AT_EXPQ(q4) do { _Pragma("unroll") for (int r = 0; r < 16; ++r) p[q4][r] = __builtin_amdgcn_exp2f(p[q4][r]); \
            pw[2 * (q4)] = (u32x4){cvtpk(p[q4][0], p[q4][1]), cvtpk(p[q4][2], p[q4][3]), cvtpk(p[q4][4], p[q4][5]), cvtpk(p[q4][6], p[q4][7])}; \
            pw[2 * (q4) + 1] = (u32x4){cvtpk(p[q4][8], p[q4][9]), cvtpk(p[q4][10], p[q4][11]), cvtpk(p[q4][12], p[q4][13]), cvtpk(p[q4][14], p[q4][15])}; } while (0)
#define AT_PVK(ks, VF) do { o0 = __builtin_amdgcn_mfma_f32_32x32x16_bf16(__builtin_bit_cast(bf16x8, pw[ks]), VF[0], o0, 0, 0, 0); \
            o1 = __builtin_amdgcn_mfma_f32_32x32x16_bf16(__builtin_bit_cast(bf16x8, pw[ks]), VF[1], o1, 0, 0, 0); \
            ol = __builtin_amdgcn_mfma_f32_32x32x16_bf16(__builtin_bit_cast(bf16x8, pw[ks]), ones, ol, 0, 0, 0); } while (0)
          bf16x8 vfa[2], vfb[2];
          vfa[0] = AT_VF(0, 0); vfa[1] = AT_VF(1, 0);
          AT_EXPQ(0);
          __builtin_amdgcn_sched_barrier(0);
#pragma unroll
          for (int q4 = 0; q4 < 4; ++q4) {
              vfb[0] = AT_VF(0, 2 * q4 + 1); vfb[1] = AT_VF(1, 2 * q4 + 1);
              AT_PVK(2 * q4, vfa);
              if (q4 + 1 < 4) { AT_EXPQ(q4 + 1); vfa[0] = AT_VF(0, 2 * q4 + 2); vfa[1] = AT_VF(1, 2 * q4 + 2); }
              AT_PVK(2 * q4 + 1, vfb);
              __builtin_amdgcn_sched_barrier(0);
          }
#undef AT_EXPQ
#undef AT_PVK
#undef AT_VF
        }
        __syncthreads();
    }
#undef AT_LOAD
#undef AT_STORE
    const int pos0 = 256 * j + wave * 32;
#pragma unroll
    for (int r = 0; r < 16; ++r) {
        const int qq = crow(r, hi); const float inv = __builtin_amdgcn_rcpf(ol[r]); const int pos = pos0 + qq;
        const int row = (j == 0) ? MLAT + b * CTXL + pos : b * SEQ + pos - CTXL;
        GAS bf16* yp = Yp + (size_t)row * DM + r32;
        yp[0] = (bf16)f2bf(o0[r] * inv); yp[32] = (bf16)f2bf(o1[r] * inv);
    }
    asm volatile("s_waitcnt lgkmcnt(0)" ::: "memory");
    __syncthreads();
}

#define XB_TMO      128
#define XB_XCNT(j)  (256  + 64 * (j))
#define XB_XSUB(j)  (1280 + 64 * (j))
#define XB_XGEN(j)  (2304 + 64 * (j))
#define XB_TOP      3328
#define XB_TOPGEN   3392
#define XCD_BAR_WORDS 3456
#define XB_SPIN_CAP (1u << 18)

__device__ __forceinline__ unsigned xb_ld(unsigned* p)              { return __hip_atomic_load(p, __ATOMIC_RELAXED, __HIP_MEMORY_SCOPE_AGENT); }
__device__ __forceinline__ unsigned xb_add(unsigned* p, unsigned v) { return __hip_atomic_fetch_add(p, v, __ATOMIC_RELAXED, __HIP_MEMORY_SCOPE_AGENT); }
__device__ __forceinline__ unsigned xb_xcc_id() { return (unsigned)__builtin_amdgcn_s_getreg((3 << 11) | 20) & 0xFu; }
#define XB_SPIN(cond, bar) do { unsigned _sp = 0; while (cond) { __builtin_amdgcn_s_sleep(1); \
    if ((++_sp & 255u) == 0u) { if (xb_ld(&(bar)[XB_TMO])) break; if (_sp > XB_SPIN_CAP) { atomicAdd(&(bar)[XB_TMO], 1u); break; } } } } while (0)

struct XcdBarrier {
    unsigned* bar; unsigned x;
    volatile LAS unsigned* st;
};

__device__ __forceinline__ XcdBarrier xcd_barrier_post(unsigned* bar, volatile LAS unsigned* st) {
    XcdBarrier b; b.bar = bar; b.x = xb_xcc_id(); b.st = st;
    if (threadIdx.x == 0) (void)xb_add(&bar[XB_XCNT(b.x)], 1u);
    return b;
}
__device__ __forceinline__ void xcd_barrier_complete(unsigned* bar, unsigned x, unsigned& nloc, unsigned& nx) {
    const unsigned G = gridDim.x * gridDim.y * gridDim.z;
    unsigned sum, cnt, mine, sp = 0u;
    for (;;) {
        sum = 0u; cnt = 0u; mine = 0u;
#pragma unroll
        for (unsigned j = 0; j < 16; ++j) { const unsigned c = xb_ld(&bar[XB_XCNT(j)]); sum += c; cnt += (c > 0u) ? 1u : 0u; mine = (j == x) ? c : mine; }
        if (sum == G) break;
        __builtin_amdgcn_s_sleep(1);
        if ((++sp & 255u) == 0u) { if (xb_ld(&bar[XB_TMO])) break; if (sp > XB_SPIN_CAP) { atomicAdd(&bar[XB_TMO], 1u); break; } }
    }
    nloc = mine > 0u ? mine : 1u; nx = cnt > 0u ? cnt : 1u;
}

__device__ __forceinline__ void xcd_barrier(const XcdBarrier& b) {
    asm volatile("s_waitcnt vmcnt(0)" ::: "memory");
    __syncthreads();
    if (threadIdx.x == 0) {
        unsigned* bar = b.bar;
        __builtin_amdgcn_s_waitcnt(0);
        unsigned nloc = b.st[0], nx = b.st[1];
        if (nloc == 0u) { xcd_barrier_complete(bar, b.x, nloc, nx); b.st[0] = nloc; b.st[1] = nx; }
        const unsigned old = xb_add(&bar[XB_XSUB(b.x)], 1u);
        const unsigned gen = old / nloc;
        if (old + 1u == (gen + 1u) * nloc) {
            __builtin_amdgcn_fence(__ATOMIC_RELEASE, "agent");
            asm volatile("s_waitcnt vmcnt(0)" ::: "memory");
            const unsigned og = xb_add(&bar[XB_TOP], 1u);
            const unsigned tg = og / nx;
            if (og + 1u == (tg + 1u) * nx) xb_add(&bar[XB_TOPGEN], 1u);
            else XB_SPIN(xb_ld(&bar[XB_TOPGEN]) == tg, bar);
            __builtin_amdgcn_fence(__ATOMIC_ACQUIRE, "agent");
            xb_add(&bar[XB_XGEN(b.x)], 1u);
            asm volatile("s_waitcnt vmcnt(0)" ::: "memory");
        } else {
            XB_SPIN(xb_ld(&bar[XB_XGEN(b.x)]) == gen, bar);
            __builtin_amdgcn_fence(__ATOMIC_ACQUIRE, "agent");
            asm volatile("s_waitcnt vmcnt(0)" ::: "memory");
        }
    }
    __syncthreads();
}

struct Args { const float* in[24]; float* out; unsigned char* ws; int ph_lo, ph_hi; };

__device__ __forceinline__ int drow_of(int n, int rmode) {
    return rmode == 0 ? n : (rmode == 1 ? 256 * (n >> 7) + (n & 127) : (rmode == 2 ? 256 * (n >> 7) + 128 + (n & 127) : 128 * (n / 96) + (n % 96)));
}
__device__ __forceinline__ void transpose_item(const float* Wg, int K, int N, bf16* WTg, int pitch, int rmode, LAS float* scr, int item, int lane) {
    const GAS float* W = (const GAS float*)Wg; GAS bf16* WT = (GAS bf16*)WTg;
    const int nblk = (N + 63) >> 6, kb = item / nblk, nb = item % nblk, k0 = 64 * kb, n0 = 64 * nb;
    const bool valid = n0 + lane < N;
    const GAS float* src = W + (size_t)k0 * N + n0 + lane;
    float val[64];
#pragma unroll
    for (int i = 0; i < 64; ++i) val[i] = valid ? src[(size_t)i * N] : 0.f;
#pragma unroll
    for (int i = 0; i < 64; ++i) scr[i * 65 + lane] = val[i];
    asm volatile("s_waitcnt lgkmcnt(0)" ::: "memory");
    const int c = lane & 7;
#pragma unroll
    for (int j = 0; j < 8; ++j) { const int nl = (lane >> 3) + 8 * j, n = n0 + nl; const LAS float* sp_ = scr + (8 * c) * 65 + nl;
        u32x4 o; o.x = pk2(sp_[0 * 65], sp_[1 * 65]); o.y = pk2(sp_[2 * 65], sp_[3 * 65]); o.z = pk2(sp_[4 * 65], sp_[5 * 65]); o.w = pk2(sp_[6 * 65], sp_[7 * 65]);
        if (n < N) *(GAS u32x4*)(WT + (size_t)drow_of(n, rmode) * pitch + k0 + 8 * c) = o; }
    asm volatile("s_waitcnt lgkmcnt(0)" ::: "memory");
}

__device__ __forceinline__ float rope_inv64(int i) { return exp2f(-(float)(2 * i) * (L2THETA / 32.0f)); }
__device__ __forceinline__ float rope_inv32(int i) { return exp2f(-(float)(2 * i) * (L2THETA / 16.0f)); }

constexpr int I_FF = 704, I_IN = 528, I_OUT = 256, I_UQ = 54, I_UKV = 48, I_L = 6 * I_FF + I_IN + I_OUT + I_UQ + I_UKV;
__device__ __forceinline__ void convert_item(const Args* ap, unsigned char* ws, int l, int r, LAS float* scr, int lane) {
    const float* W; bf16* WT; int K, N, pitch, rmode, idx;
    if (r < 6 * I_FF) {
        const int j = r / (3 * I_FF), r2 = r % (3 * I_FF), which = r2 / I_FF, lj = l * 2 + j; idx = r2 % I_FF;
        if (which < 2) { W = ap->in[7 + which] + (size_t)lj * DM * DFF; K = DM; N = DFF; WT = (bf16*)(ws + WS_WGU + lj * SZ_WGU); pitch = DM; rmode = 1 + which; }
        else { W = ap->in[9] + (size_t)lj * DFF * DM; K = DFF; N = DM; WT = (bf16*)(ws + WS_WD + lj * SZ_WD); pitch = DFF; rmode = 0; }
    } else {
        r -= 6 * I_FF;
        if (r < I_IN) { W = ap->in[10] + (size_t)l * DM * INC; K = DM; N = INC; WT = (bf16*)(ws + WS_WIN + l * SZ_WIN); pitch = DM; rmode = 0; idx = r; }
        else if (r < I_IN + I_OUT) { W = ap->in[11] + (size_t)l * DM * DM; K = DM; N = DM; WT = (bf16*)(ws + WS_WOUT + l * SZ_WOUT); pitch = DM; rmode = 0; idx = r - I_IN; }
        else if (r < I_IN + I_OUT + I_UQ) { W = ap->in[18] + (size_t)l * 384 * 576; K = 384; N = 576; WT = (bf16*)(ws + WS_WUP + l * SZ_WUP); pitch = 640; rmode = 3; idx = r - I_IN - I_OUT; }
        else { W = ap->in[19] + (size_t)l * 256 * 768; K = 256; N = 768; WT = (bf16*)(ws + WS_WUP + l * SZ_WUP) + (size_t)768 * 640 + 384; pitch = 640; rmode = 0; idx = r - I_IN - I_OUT - I_UQ; }
    }
    transpose_item(W, K, N, WT, pitch, rmode, scr, idx, lane);
}

__global__ void __launch_bounds__(512, 2) fwd_mega(Args args) {
    extern __shared__ __attribute__((aligned(16))) unsigned char lds[];
    cg::grid_group grid = cg::this_grid();
    LAS unsigned char* ldsl = (LAS unsigned char*)lds;

    const int ph_lo = args.ph_lo, ph_hi = args.ph_hi;
    volatile LAS unsigned* xst = (volatile LAS unsigned*)((LAS unsigned char*)lds + LDS_BYTES - 64);
    if (threadIdx.x == 0) { xst[0] = 0u; xst[1] = 0u; }
    __syncthreads();
    const XcdBarrier xbar = xcd_barrier_post((unsigned*)(args.ws + WS_CTL), xst);
    const int wave0 = __builtin_amdgcn_readfirstlane(threadIdx.x >> 6);
    const Args* ap = (const Args*)__builtin_amdgcn_kernarg_segment_ptr();
#if DBL
    bool redo = false;
#endif
    for (int ph = ph_lo; ph < ph_hi; ++ph) {
        asm volatile("" : "+s"(ap));
        ap = uptr(ap);
        int lane_ = __lane_id(); asm volatile("" : "+v"(lane_));
        const int tid = wave0 * 64 + lane_;
        int G = gridDim.x, bx = blockIdx.x; asm volatile("" : "+s"(G), "+s"(bx));
        const int lane = lane_, wave = wave0;
        const int gw = bx * 8 + wave, NGW = G * 8;
        unsigned char* ws = uptr(ap->ws);
        float* MOD = (float*)(ws + WS_MOD);
        if (ph == 0) { if constexpr ((EN & 1) != 0) {
            {
                LAS float* scr = (LAS float*)(ldsl + wave * 16640);
                for (int it = gw; it < I_L; it += NGW) convert_item(ap, ws, 0, it, scr, lane);
            }
            {
                const GAS f32x4* xs = (const GAS f32x4*)ap->in[0]; const GAS f32x4* cs = (const GAS f32x4*)ap->in[2]; GAS u32x4* xd = (GAS u32x4*)(ws + WS_X);
                const int nl = MLAT * DM / 8, nc = MCTX * DM / 8;
                for (int i = bx * 512 + tid; i < nl; i += G * 512) { const f32x4 a = xs[2 * i], c = xs[2 * i + 1]; xd[i] = (u32x4){cvtpk(a.x, a.y), cvtpk(a.z, a.w), cvtpk(c.x, c.y), cvtpk(c.z, c.w)}; }
                for (int i = bx * 512 + tid; i < nc; i += G * 512) { const f32x4 a = cs[2 * i], c = cs[2 * i + 1]; xd[nl + i] = (u32x4){cvtpk(a.x, a.y), cvtpk(a.z, a.w), cvtpk(c.x, c.y), cvtpk(c.z, c.w)}; }
            }
            {
                for (int i = bx * 512 + tid; i < DEPTH * 1536 * 80; i += G * 512) {
                    const int l = i / (1536 * 80), r2 = i % (1536 * 80), row = r2 / 80, ch = r2 % 80;
                    const bool z = row < 768 ? (ch >= 48) : (ch < 48);
                    if (z) *(u32x4*)((bf16*)(ws + WS_WUP + l * SZ_WUP) + (size_t)row * 640 + ch * 8) = (u32x4){0u, 0u, 0u, 0u};
                }
            }
            __syncthreads();
            {
                LAS float* S = (LAS float*)ldsl;
                LAS float* red = (LAS float*)(ldsl + 36864);
                for (int i = tid; i < 9 * DM; i += 512) { const int r = i >> 10, k = i & 1023; const float v = r < 8 ? ap->in[1][r * DM + k] : ap->in[3][k]; S[i] = v / (1.0f + expf(-v)); }
                __syncthreads();
                for (int item = bx; item < DEPTH * 36; item += G) {
                    const int l = item / 36, n0 = (item % 36) * 256;
                    f32x4 acc[9];
#pragma unroll
                    for (int r = 0; r < 9; ++r) acc[r] = (f32x4){0.f, 0.f, 0.f, 0.f};
                    const GAS float* w = (const GAS float*)ap->in[4] + (size_t)l * DM * (NMOD * DM) + (size_t)(wave * 128) * (NMOD * DM) + n0 + 4 * lane;
#pragma unroll 16
                    for (int kk = 0; kk < 128; ++kk) {
                        const f32x4 wv = *(const GAS f32x4*)(w + (size_t)kk * (NMOD * DM));
#pragma unroll
                        for (int r = 0; r < 9; ++r) acc[r] += wv * S[r * DM + wave * 128 + kk];
                    }
#pragma unroll
                    for (int r = 0; r < 9; ++r) *(LAS f32x4*)(red + (wave * 9 + r) * 256 + 4 * lane) = acc[r];
                    __syncthreads();
                    for (int o = tid; o < 9 * 256; o += 512) {
                        const int r = o >> 8, cc = o & 255; float sm = ap->in[5][l * (NMOD * DM) + n0 + cc];
#pragma unroll
                        for (int k2 = 0; k2 < 8; ++k2) sm += red[(k2 * 9 + r) * 256 + cc];
                        MOD[(size_t)(l * 9 + r) * (NMOD * DM) + n0 + cc] = sm;
                    }
                    __syncthreads();
                }
            }
        } } else {
            const int l = (ph - 1) / 13, sp = (ph - 1) % 13;
            const bool last = (l == DEPTH - 1);
            const float* modl = MOD + (size_t)l * 9 * (NMOD * DM);
            if ((EN & 2) && (sp == 0 || sp == 3 || sp == 10)) {
                const int which = sp == 0 ? 0 : (sp == 3 ? 1 : 2);
                const int kshift = which == 0 ? 0 : (which == 1 ? 3 : 6);
                const int nrows = (sp == 10 && last) ? MLAT : MTOT;
                GAS bf16* X = (GAS bf16*)(ws + WS_X); GAS bf16* Hb = (GAS bf16*)(ws + WS_H);
                const GAS float* gn = (const GAS float*)ap->in[6] + (size_t)(l * 3 + which) * DM;
                float gg[16], am[16], bm[16];
#pragma unroll
                for (int j = 0; j < 2; ++j)
#pragma unroll
                    for (int e = 0; e < 8; ++e) { gg[8 * j + e] = gn[512 * j + 8 * lane + e]; am[8 * j + e] = 0.f; bm[8 * j + e] = 0.f; }
                const int rpc = nrows > MLAT ? (MCTX + NGW - 1) / NGW : 0, rpl = (MLAT + NGW - 1) / NGW, nk = rpc + rpl;
#define ROWOF(k) ((k) < rpc ? ((gw * rpc + (k)) < MCTX ? MLAT + gw * rpc + (k) : -1) : ((gw * rpl + (k) - rpc) < MLAT ? gw * rpl + (k) - rpc : -1))
#define XLOAD(dst, row) do { const GAS u32x4* xr_ = (const GAS u32x4*)(X + (size_t)(row) * DM) + lane; dst[0] = xr_[0]; dst[1] = xr_[64]; } while (0)
                u32x4 va[2], vb[2], vc[2];
                va[0] = va[1] = vb[0] = vb[1] = vc[0] = vc[1] = (u32x4){0u, 0u, 0u, 0u};
                { const int ra = ROWOF(0); if (nk > 0 && ra >= 0) XLOAD(va, ra); }
                { const int rb = ROWOF(1); if (nk > 1 && rb >= 0) XLOAD(vb, rb); }
                int cur_mr = -1;
                const bool haspart = (sp != 0 || l > 0) && (256 % G) == 0;
                u32x4 pq[SPLITS][2];
                const int r_first = ROWOF(0); const bool pf = haspart && nk > 0 && r_first >= MLAT;
#pragma unroll
                for (int sq = 0; sq < SPLITS; ++sq) { pq[sq][0] = (u32x4){0u, 0u, 0u, 0u}; pq[sq][1] = pq[sq][0]; }
                if (pf) {
#pragma unroll
                    for (int sq = 0; sq < SPLITS; ++sq) { const GAS bf16* pr = (const GAS bf16*)(ws + WS_PART) + ((size_t)sq * MCTX + (r_first - MLAT)) * DM + 8 * lane;
                        pq[sq][0] = *(const GAS u32x4*)pr; pq[sq][1] = *(const GAS u32x4*)(pr + 512); } }
                for (int k = 0; k < nk; ++k) {
                    const int r = ROWOF(k);
                    { const int rc = ROWOF(k + 2); if (k + 2 < nk && rc >= 0) XLOAD(vc, rc); }
                    if (r >= 0) {
                    const int mr = r < MLAT ? (r >> 11) : 8;
                    if (mr != cur_mr) { cur_mr = mr; const GAS float* sh = (const GAS float*)modl + (size_t)mr * (NMOD * DM) + kshift * DM; const GAS float* sc = sh + DM;
#pragma unroll
                        for (int j = 0; j < 2; ++j)
#pragma unroll
                            for (int e = 0; e < 8; ++e) { am[8 * j + e] = gg[8 * j + e] * (sc[512 * j + 8 * lane + e] + 1.0f); bm[8 * j + e] = sh[512 * j + 8 * lane + e]; } }
                    float v[16];
#pragma unroll
                    for (int j = 0; j < 2; ++j) { const u32x4 u = va[j];
                        v[8 * j + 0] = __builtin_bit_cast(float, u.x << 16); v[8 * j + 1] = __builtin_bit_cast(float, u.x & 0xffff0000u); v[8 * j + 2] = __builtin_bit_cast(float, u.y << 16); v[8 * j + 3] = __builtin_bit_cast(float, u.y & 0xffff0000u);
                        v[8 * j + 4] = __builtin_bit_cast(float, u.z << 16); v[8 * j + 5] = __builtin_bit_cast(float, u.z & 0xffff0000u); v[8 * j + 6] = __builtin_bit_cast(float, u.w << 16); v[8 * j + 7] = __builtin_bit_cast(float, u.w & 0xffff0000u); }
                    if (haspart && r >= MLAT) {
#pragma unroll
                        for (int sq = 0; sq < SPLITS; ++sq) { const GAS bf16* pr = (const GAS bf16*)(ws + WS_PART) + ((size_t)sq * MCTX + (r - MLAT)) * DM + 8 * lane;
#pragma unroll
                            for (int j = 0; j < 2; ++j) { const u32x4 a = (pf && k == 0) ? pq[sq][j] : *(const GAS u32x4*)(pr + 512 * j);
                                v[8 * j + 0] += __builtin_bit_cast(float, a.x << 16); v[8 * j + 1] += __builtin_bit_cast(float, a.x & 0xffff0000u); v[8 * j + 2] += __builtin_bit_cast(float, a.y << 16); v[8 * j + 3] += __builtin_bit_cast(float, a.y & 0xffff0000u);
                                v[8 * j + 4] += __builtin_bit_cast(float, a.z << 16); v[8 * j + 5] += __builtin_bit_cast(float, a.z & 0xffff0000u); v[8 * j + 6] += __builtin_bit_cast(float, a.w << 16); v[8 * j + 7] += __builtin_bit_cast(float, a.w & 0xffff0000u); } }
                        GAS u32x4* xw = (GAS u32x4*)(X + (size_t)r * DM) + lane;
#pragma unroll
                        for (int j = 0; j < 2; ++j) { const u32x4 o = (u32x4){cvtpk(v[8 * j], v[8 * j + 1]), cvtpk(v[8 * j + 2], v[8 * j + 3]), cvtpk(v[8 * j + 4], v[8 * j + 5]), cvtpk(v[8 * j + 6], v[8 * j + 7])}; xw[64 * j] = o;
                            v[8 * j + 0] = __builtin_bit_cast(float, o.x << 16); v[8 * j + 1] = __builtin_bit_cast(float, o.x & 0xffff0000u); v[8 * j + 2] = __builtin_bit_cast(float, o.y << 16); v[8 * j + 3] = __builtin_bit_cast(float, o.y & 0xffff0000u);
                            v[8 * j + 4] = __builtin_bit_cast(float, o.z << 16); v[8 * j + 5] = __builtin_bit_cast(float, o.z & 0xffff0000u); v[8 * j + 6] = __builtin_bit_cast(float, o.w << 16); v[8 * j + 7] = __builtin_bit_cast(float, o.w & 0xffff0000u); }
                    }
                    float ss = 0.f;
#pragma unroll
                    for (int e = 0; e < 16; ++e) ss += v[e] * v[e];
                    const float rstd = rsqrtf(wave_sum(ss, lane) * (1.0f / DM) + EPS);
                    GAS u32x4* o8 = (GAS u32x4*)(Hb + (size_t)r * DM) + lane;
#pragma unroll
                    for (int j = 0; j < 2; ++j) { float y[8];
#pragma unroll
                        for (int e = 0; e < 8; ++e) y[e] = v[8 * j + e] * rstd * am[8 * j + e] + bm[8 * j + e];
                        o8[64 * j] = (u32x4){cvtpk(y[0], y[1]), cvtpk(y[2], y[3]), cvtpk(y[4], y[5]), cvtpk(y[6], y[7])}; }
                    }
                    va[0] = vb[0]; va[1] = vb[1]; vb[0] = vc[0]; vb[1] = vc[1];
                }
#undef ROWOF
#undef XLOAD
            } else if ((EN & 32) && sp == 5) {
                const GAS bf16* P = (const GAS bf16*)(ws + WS_P);
                GAS bf16* CQKV = (GAS bf16*)(ws + WS_CQKV); GAS bf16* QA = (GAS bf16*)(ws + WS_QA); GAS bf16* KA = (GAS bf16*)(ws + WS_KA);
                GAS bf16* VA = (GAS bf16*)(ws + WS_VA); GAS bf16* KM = (GAS bf16*)(ws + WS_KM); GAS bf16* YC = (GAS bf16*)(ws + WS_YC);
                const int hh = lane >> 3, dim0 = (lane & 7) * 8;
                float g8[8], inv8[8], ik8[8], gkr8[8], gc0[8], gc1[8], cw0[4], cw1[4], cw2[4], cb4[4];
                { const float* gsrc = (hh < 6 ? ap->in[12] : ap->in[13]) + l * 64 + dim0;
                  const float* gcq = ap->in[16] + l * 384; const float* gckv = ap->in[17] + l * 256; const float* gkr = ap->in[23] + l * 32 + (lane & 3) * 8;
                  const float* cw = ap->in[14] + l * 3 * 256 + 4 * lane; const float* cb = ap->in[15] + l * 256 + 4 * lane;
#pragma unroll
                  for (int e = 0; e < 8; ++e) { g8[e] = gsrc[e] * (hh < 6 ? QSCALE_A : 1.0f); inv8[e] = rope_inv64((lane & 1) * 8 + e); ik8[e] = rope_inv32(e); gkr8[e] = gkr[e];
                      gc0[e] = lane < 48 ? gcq[8 * lane + e] : gckv[8 * (lane - 48) + e]; gc1[e] = gckv[128 + 8 * (lane & 15) + e]; }
#pragma unroll
                  for (int i = 0; i < 4; ++i) { cw0[i] = cw[i]; cw1[i] = cw[256 + i]; cw2[i] = cw[512 + i]; cb4[i] = cb[i]; } }
#define UNPK8(u, f) do { f[0] = __builtin_bit_cast(float, (u).x << 16); f[1] = __builtin_bit_cast(float, (u).x & 0xffff0000u); f[2] = __builtin_bit_cast(float, (u).y << 16); f[3] = __builtin_bit_cast(float, (u).y & 0xffff0000u); \
                          f[4] = __builtin_bit_cast(float, (u).z << 16); f[5] = __builtin_bit_cast(float, (u).z & 0xffff0000u); f[6] = __builtin_bit_cast(float, (u).w << 16); f[7] = __builtin_bit_cast(float, (u).w & 0xffff0000u); } while (0)
#define PK8(f) ((u32x4){cvtpk(f[0], f[1]), cvtpk(f[2], f[3]), cvtpk(f[4], f[5]), cvtpk(f[6], f[7])})
                for (int r = gw; r < MTOT; r += NGW) {
                    const bool lat = r < MLAT; int b, s;
                    if (lat) { b = r >> 11; s = r & 2047; } else { b = (r - MLAT) >> 8; s = (r - MLAT) & 255; }
                    const int pos = lat ? CTXL + s : s, smax = lat ? SEQ - 1 : CTXL - 1;
                    const float prow = (float)(s >> 6), pcol = (float)(s & 63);
                    const GAS bf16* p = P + (size_t)r * INP;
                    const u32x4 a8 = *(const GAS u32x4*)(p + 8 * lane);
                    const u32x4 v8 = *(const GAS u32x4*)(p + PC_V + 8 * (lane & 15));
                    const u32x4 c0 = *(const GAS u32x4*)(p + PC_CQ + 8 * lane);
                    const u32x4 c1 = *(const GAS u32x4*)(p + PC_CQ + 512 + 8 * (lane & 15));
                    const u32x4 k8 = *(const GAS u32x4*)(p + PC_KR + 8 * (lane & 3));
                    const u32x2 xi = *(const GAS u32x2*)(p + PC_X + 4 * lane), cg = *(const GAS u32x2*)(p + PC_CG + 4 * lane), bg = *(const GAS u32x2*)(p + PC_BG + 4 * lane);
                    u32x2 xm = (u32x2){0u, 0u}, cm = xm, xp = xm, cp = xm;
                    if (s > 0) { xm = *(const GAS u32x2*)(p - INP + PC_X + 4 * lane); cm = *(const GAS u32x2*)(p - INP + PC_CG + 4 * lane); }
                    if (s < smax) { xp = *(const GAS u32x2*)(p + INP + PC_X + 4 * lane); cp = *(const GAS u32x2*)(p + INP + PC_CG + 4 * lane); }
                    { float v[8]; UNPK8(a8, v); float ss = 0.f;
#pragma unroll
                      for (int e = 0; e < 8; ++e) ss += v[e] * v[e];
                      ss += dpp_x1(ss); ss += dpp_x2(ss); ss += dpp_hm(ss);
                      const float rs = rsqrtf(ss * (1.0f / 64.0f) + EPS);
#pragma unroll
                      for (int e = 0; e < 8; ++e) v[e] = v[e] * rs * g8[e];
                      if (lat) { const float posv = (lane & 7) < 4 ? prow : pcol;
#pragma unroll
                          for (int e = 0; e < 8; ++e) { const float ang = posv * inv8[e], c = __cosf(ang), sn = __sinf(ang); const float yp = dpp_x2(v[e]);
                              v[e] = (lane & 2) ? v[e] * c + yp * sn : v[e] * c - yp * sn; } }
                      GAS bf16* dst = hh < 6 ? QA + ((size_t)(b * 6 + hh) * LKV + pos) * 64 + dim0 : KA + ((size_t)(b * 2 + hh - 6) * LKV + pos) * 64 + dim0;
                      *(GAS u32x4*)dst = PK8(v); }
                    if (lane < 16) *(GAS u32x4*)(VA + ((size_t)(b * 2 + (lane >> 3)) * LKV + pos) * 64 + (lane & 7) * 8) = v8;
                    { float w[8]; UNPK8(k8, w); float ss = 0.f;
#pragma unroll
                      for (int e = 0; e < 8; ++e) ss += w[e] * w[e];
                      ss += dpp_x1(ss); ss += dpp_x2(ss);
                      const float rs = rsqrtf(ss * (1.0f / 32.0f) + EPS);
#pragma unroll
                      for (int e = 0; e < 8; ++e) w[e] = w[e] * rs * gkr8[e];
                      if (lat) { const float posv = (lane & 3) < 2 ? prow : pcol;
#pragma unroll
                          for (int e = 0; e < 8; ++e) { const float ang = posv * ik8[e], c = __cosf(ang), sn = __sinf(ang); const float zp = dpp_x1(w[e]);
                              w[e] = (lane & 1) ? w[e] * c + zp * sn : w[e] * c - zp * sn; } }
                      if (lane < 24) *(GAS u32x4*)(KM + ((size_t)(b * 6 + (lane >> 2)) * LKV + pos) * 96 + 64 + (lane & 3) * 8) = PK8(w); }
                    { float q0[8], q1[8]; UNPK8(c0, q0); UNPK8(c1, q1); float s0 = 0.f, s1 = 0.f;
#pragma unroll
                      for (int e = 0; e < 8; ++e) { s0 += q0[e] * q0[e]; s1 += q1[e] * q1[e]; }
                      const float sq = wave_sum(lane < 48 ? s0 : 0.f, lane), sk = wave_sum((lane >= 48 ? s0 : 0.f) + (lane < 16 ? s1 : 0.f), lane);
                      const float rq = rsqrtf(sq * (1.0f / 384.0f) + EPS), rk = rsqrtf(sk * (1.0f / 256.0f) + EPS), r0 = lane < 48 ? rq : rk;
#pragma unroll
                      for (int e = 0; e < 8; ++e) { q0[e] = q0[e] * r0 * gc0[e]; q1[e] = q1[e] * rk * gc1[e]; }
                      *(GAS u32x4*)(CQKV + (size_t)r * 640 + 8 * lane) = PK8(q0);
                      if (lane < 16) *(GAS u32x4*)(CQKV + (size_t)r * 640 + 512 + 8 * lane) = PK8(q1); }
                    { float y[4];
#pragma unroll
                      for (int i = 0; i < 4; ++i) {
                          const unsigned xw = i < 2 ? xi.x : xi.y, cgw = i < 2 ? cg.x : cg.y, bgw = i < 2 ? bg.x : bg.y, xmw = i < 2 ? xm.x : xm.y, cmw = i < 2 ? cm.x : cm.y, xpw = i < 2 ? xp.x : xp.y, cpw = i < 2 ? cp.x : cp.y;
#define HALF16(wd) __builtin_bit_cast(float, (i & 1) ? ((wd) & 0xffff0000u) : ((wd) << 16))
                          const float u1 = HALF16(cgw) * HALF16(xw), u0 = HALF16(cmw) * HALF16(xmw), u2 = HALF16(cpw) * HALF16(xpw);
                          y[i] = HALF16(bgw) * (u0 * cw0[i] + u1 * cw1[i] + u2 * cw2[i] + cb4[i]);
#undef HALF16
                      }
                      *(GAS u32x2*)(YC + (size_t)r * DM + 384 + 4 * lane) = (u32x2){cvtpk(y[0], y[1]), cvtpk(y[2], y[3])}; }
                }
            } else if ((EN & 128) && sp == 7) {
                const GAS bf16* QKVR = (const GAS bf16*)(ws + WS_QKVR); GAS bf16* QM = (GAS bf16*)(ws + WS_QM); GAS bf16* KM = (GAS bf16*)(ws + WS_KM); GAS bf16* VM = (GAS bf16*)(ws + WS_VM);
                const int sub = lane & 15;
                float gs0[8], gs1[8], gs2[8], ik8[8];
                { const float* gqn = ap->in[20] + l * 64; const float* gkn = ap->in[21] + l * 64; const float* gqr = ap->in[22] + l * 32;
#pragma unroll
                  for (int e = 0; e < 8; ++e) {
                      const float gq = sub < 8 ? gqn[8 * sub + e] * QSCALE_M : (sub < 12 ? gqr[8 * (sub - 8) + e] * QSCALE_M : 0.f);
                      const float gk = sub < 8 ? gkn[8 * sub + e] : 0.f;
                      gs0[e] = gq; gs1[e] = lane < 32 ? gq : gk; gs2[e] = gk; ik8[e] = rope_inv32(e); } }
                const float invn_q = sub < 8 ? (1.0f / 64.0f) : (1.0f / 32.0f);
                for (int r = gw; r < MTOT; r += NGW) {
                    const bool lat = r < MLAT; int b, s;
                    if (lat) { b = r >> 11; s = r & 2047; } else { b = (r - MLAT) >> 8; s = (r - MLAT) & 255; }
                    const int pos = lat ? CTXL + s : s;
                    const float posv = sub < 10 ? (float)(s >> 6) : (float)(s & 63);
                    const GAS bf16* q = QKVR + (size_t)r * 1536 + 8 * lane;
                    const u32x4 d0 = *(const GAS u32x4*)q, d1 = *(const GAS u32x4*)(q + 512), d2 = *(const GAS u32x4*)(q + 1024);
#pragma unroll
                    for (int i = 0; i < 3; ++i) {
                        const u32x4 d = i == 0 ? d0 : (i == 1 ? d1 : d2);
                        const bool isq = i == 0 || (i == 1 && lane < 32);
                        const int head = i == 0 ? (lane >> 4) : (i == 1 ? (lane < 32 ? 4 + (lane >> 4) : (lane >> 4) - 2) : 2 + (lane >> 4));
                        float v[8]; UNPK8(d, v);
                        const bool pad = isq && sub >= 12;
                        float ss = 0.f;
#pragma unroll
                        for (int e = 0; e < 8; ++e) { v[e] = pad ? 0.f : v[e]; ss += v[e] * v[e]; }
                        ss += dpp_x1(ss); ss += dpp_x2(ss); ss += dpp_hm(ss);
                        const float rs = rsqrtf(ss * (isq ? invn_q : (1.0f / 64.0f)) + EPS);
#pragma unroll
                        for (int e = 0; e < 8; ++e) v[e] = v[e] * rs * (i == 0 ? gs0[e] : (i == 1 ? gs1[e] : gs2[e]));
                        if (i < 2 && lat) {
                            const bool rp = isq && sub >= 8 && sub < 12;
#pragma unroll
                            for (int e = 0; e < 8; ++e) { const float ang = posv * ik8[e], c = __cosf(ang), sn = __sinf(ang); const float yp = dpp_x1(v[e]);
                                const float rot = (sub & 1) ? v[e] * c + yp * sn : v[e] * c - yp * sn; v[e] = rp ? rot : v[e]; }
                        }
                        const size_t tok = (size_t)(b * 6 + head) * LKV + pos;
                        if (isq) { if (!pad) *(GAS u32x4*)(QM + tok * 96 + (sub < 8 ? 8 * sub : 64 + 8 * (sub - 8))) = PK8(v); }
                        else if (sub < 8) *(GAS u32x4*)(KM + tok * 96 + 8 * sub) = PK8(v);
                        else *(GAS u32x4*)(VM + tok * 64 + 8 * (sub - 8)) = d;
                    }
                }
#undef UNPK8
#undef PK8
            } else if ((EN & 256) && sp == 8) {
                const int vcu = (G % 8 == 0) ? (bx % 8) * (G / 8) + bx / 8 : bx;
                const int nh = (768 - vcu + G - 1) / G;
                for (int k = 0; k < nh + 1; ++k) {
                    int kind, bh, j;
                    if (k < nh) { const int u = vcu + k * G; kind = u < 384 ? 1 : 0; const int rem = u % 384; bh = rem >> 3; j = 1 + (rem & 7); }
                    else { const int u2 = G - 1 - vcu; if (last || u2 >= 96 || u2 < 0) break; kind = u2 < 48 ? 1 : 0; bh = u2 % 48; j = 0; }
                    const int b = bh / 6, h = bh % 6, nk = j == 0 ? CTXL : LKV;
                    if (kind) attn_unit<96>(ldsl, (const GAS bf16*)(ws + WS_QM) + (size_t)bh * LKV * 96, (const GAS bf16*)(ws + WS_KM) + (size_t)bh * LKV * 96, (const GAS bf16*)(ws + WS_VM) + (size_t)bh * LKV * 64,
                                            (GAS bf16*)(ws + WS_YC) + 640 + h * 64, b, j, nk, tid, lane, wave);
                    else attn_unit<64>(ldsl, (const GAS bf16*)(ws + WS_QA) + (size_t)bh * LKV * 64, (const GAS bf16*)(ws + WS_KA) + (size_t)(b * 2 + h / 3) * LKV * 64, (const GAS bf16*)(ws + WS_VA) + (size_t)(b * 2 + h / 3) * LKV * 64,
                                       (GAS bf16*)(ws + WS_YC) + h * 64, b, j, nk, tid, lane, wave);
                }
            } else if ((EN & 4) && (sp == 1 || sp == 11)) {
                const int lj = l * 2 + (sp == 11 ? 1 : 0); const int M = (sp == 11 && last) ? MLAT : MTOT;
                pg8::Gemm g{(const bf16*)(ws + WS_H), (const bf16*)(ws + WS_WGU + lj * SZ_WGU), M, NGU, DM}; pg8::StaticOrder S; S.init(M, NGU, G, bx, DM);
                pg8::EpiSwiGLU E{(bf16*)(ws + WS_GU)};
                pg8::gemm_phase<pg8::EpiSwiGLU, pg8::StaticOrder, true, true>(ldsl, g, S, E, tid);
                if (l + 1 < DEPTH) {
                    const int nfull = S.nwg / G, nbusy = S.nwg - nfull * G;
                    if (bx >= nbusy && nbusy > 0) {
                        __syncthreads();
                        int lane2 = __lane_id(); asm volatile("" : "+v"(lane2));
                        LAS float* scr = (LAS float*)((LAS unsigned char*)lds + wave * 16640);
                        const int half = (I_L + 1) / 2, first = sp == 1 ? 0 : half, lastit = sp == 1 ? half : I_L, nw = (G - nbusy) * 8;
                        for (int it = first + (bx - nbusy) * 8 + wave; it < lastit; it += nw) convert_item(ap, ws, l + 1, it, scr, lane2);
                    }
                }
            } else if ((EN & 8) && (sp == 2 || sp == 12 || sp == 9)) {
                const int lj = l * 2 + (sp == 12 ? 1 : 0); const int M = (sp != 2 && last) ? MLAT : MTOT;
                bf16* Xp = (bf16*)(ws + WS_X);
                pg8::Gemm g{uptr((const bf16*)(ws + (sp == 9 ? WS_YC : WS_GU))), uptr((const bf16*)(sp == 9 ? ws + WS_WOUT + l * SZ_WOUT : ws + WS_WD + lj * SZ_WD)), M, DM, __builtin_amdgcn_readfirstlane(sp == 9 ? DM : DFF)};
                const int Kd = __builtin_amdgcn_readfirstlane(sp == 9 ? DM : DFF);
                pg8::LatCtxOrder S; S.init(M, G, bx, Kd, SPLITS);
                pg8::EpiResid E{uptr(Xp), uptr(Xp), uptr((sp == 12 && last) ? ap->out : (float*)nullptr), uptr(modl), __builtin_amdgcn_readfirstlane(sp == 2 ? 2 : (sp == 9 ? 5 : 8)), __builtin_bit_cast(float, __builtin_amdgcn_readfirstlane(sp == 9 ? 0x3f800000 : 0x3f000000))};
                pg8::gemm_phase<pg8::EpiResid, pg8::LatCtxOrder, true, true>(ldsl, g, S, E, tid);
            } else if ((EN & 16) && (sp == 4 || sp == 6)) {
                const bf16* A; const bf16* Bt; bf16* O; int N, K;
                if (sp == 4) { A = (const bf16*)(ws + WS_H); Bt = (const bf16*)(ws + WS_WIN + l * SZ_WIN); O = (bf16*)(ws + WS_P); N = INP; K = DM; }
                else { A = (const bf16*)(ws + WS_CQKV); Bt = (const bf16*)(ws + WS_WUP + l * SZ_WUP); O = (bf16*)(ws + WS_QKVR); N = 1536; K = 640; }
                pg8::Gemm g{uptr(A), uptr(Bt), MTOT, __builtin_amdgcn_readfirstlane(N), __builtin_amdgcn_readfirstlane(K)}; pg8::BdOrder S; S.init(MTOT, N, G, bx, K, sp == 6);
                pg8::EpiBf16<0> E{uptr(O), __builtin_amdgcn_readfirstlane(N), nullptr, 0, 0, 1.f};
                pg8::gemm_phase<pg8::EpiBf16<0>, pg8::BdOrder, true, true>(ldsl, g, S, E, tid);
            }
        }
        if (ph + 1 < ph_hi) { if (ph_hi < 0) grid.sync(); else xcd_barrier(xbar); }
#if DBL
        { const int bit = ph == 0 ? 13 : (ph - 1) % 13;
          if (!redo && ((DBL >> bit) & 1)) { redo = true; --ph; } else redo = false; }
#endif
    }
}

extern "C" void kernel_launch(void* const* d_in, const int* in_sizes, int n_in, void* d_out, int out_size, void* d_ws, size_t ws_size, hipStream_t stream) {
    static int grid_blocks = 0;
    if (grid_blocks == 0) {
        if (n_in != 24 || out_size != MLAT * DM || ws_size < WS_END) { fprintf(stderr, "kernel_launch: unexpected problem (n_in %d out %d ws %zu need %zu)\n", n_in, out_size, ws_size, (size_t)WS_END); grid_blocks = -1; return; }
        int dev = 0, cus = 0, per_cu = 0;
        (void)hipGetDevice(&dev);
        (void)hipDeviceGetAttribute(&cus, hipDeviceAttributeMultiprocessorCount, dev);
        (void)hipFuncSetAttribute((const void*)fwd_mega, hipFuncAttributeMaxDynamicSharedMemorySize, LDS_BYTES);
        (void)hipOccupancyMaxActiveBlocksPerMultiprocessor(&per_cu, (const void*)fwd_mega, 512, LDS_BYTES);
        if (per_cu < 1) per_cu = 1;
        grid_blocks = cus * per_cu;
        fprintf(stderr, "kernel_launch: grid %d (cus %d x %d), ws %zu need %zu\n", grid_blocks, cus, per_cu, ws_size, (size_t)WS_END);
    }
    if (grid_blocks < 0) return;
    if (hipMemsetAsync((char*)d_ws + WS_CTL, 0, CTL_BYTES, stream) != hipSuccess) { fprintf(stderr, "kernel_launch: memset of the barrier words failed\n"); return; }
    Args a{};
    for (int i = 0; i < 24; ++i) a.in[i] = (const float*)d_in[i];
    a.out = (float*)d_out; a.ws = (unsigned char*)d_ws;
#if MK_MULTI
    for (int ph = 0; ph < NPHASE; ++ph) {
        a.ph_lo = ph; a.ph_hi = ph + 1;
        void* kargs[] = {&a};
        hipError_t e = hipLaunchCooperativeKernel((const void*)fwd_mega, dim3(grid_blocks), dim3(512), kargs, LDS_BYTES, stream);
        if (e != hipSuccess) { fprintf(stderr, "kernel_launch: cooperative launch failed: %s\n", hipGetErrorString(e)); break; }
    }
#else
    a.ph_lo = 0; a.ph_hi = NPHASE;
    void* kargs[] = {&a};
    hipError_t e = hipLaunchCooperativeKernel((const void*)fwd_mega, dim3(grid_blocks), dim3(512), kargs, LDS_BYTES, stream);
    if (e != hipSuccess) fprintf(stderr, "kernel_launch: cooperative launch failed: %s\n", hipGetErrorString(e));
#endif
}
```

```cpp
#include <hip/hip_runtime.h>
#include <hip/hip_cooperative_groups.h>
#include <cstdio>
#include <cstdint>
namespace cg = cooperative_groups;
namespace pg8 {
#define PG8_LAS __attribute__((address_space(3)))
typedef unsigned short bf16_t;
typedef short bf16x8 __attribute__((ext_vector_type(8)));
typedef float f32x4 __attribute__((ext_vector_type(4)));
typedef unsigned u32x4 __attribute__((ext_vector_type(4)));
constexpr int BM = 256, BK = 64, HALF = 128, HTB = HALF * BK * 2  , STAGE_BYTES = 8 * HTB, NXCD = 8, WGM = 8;

__host__ __device__ __forceinline__ int lds_byte(int r, int c) { const int st = (r >> 4) * 2 + (c >> 5), rr = r & 15, cc = c & 31, ob = rr * 64 + cc * 2; return st * 1024 + (ob ^ (((ob >> 9) & 1) << 5)); }
__host__ __device__ __forceinline__ void stage_rc(int b, int& R, int& C) { const int st = b / 1024, sb = b % 1024, swz = sb ^ (((sb >> 9) & 1) << 5); R = (st >> 1) * 16 + swz / 64; C = (st & 1) * 32 + (swz % 64) / 2; }
__host__ __device__ __forceinline__ int perm32(int rho) { const int n = rho >> 4, i = rho & 15; return 8 * (i >> 2) + 4 * n + (i & 3); }

struct Unit { int pm, pn, kt0, ntk, part; };
struct Gemm { const bf16_t* A; const bf16_t* Bt; int M, N, K; };

struct StaticOrder {
    int nM, nN, nwg, G, c, ntk;
    __host__ __device__ void init(int M, int N, int G_, int c_, int K_) { nM = M / BM; nN = N / BM; nwg = nM * nN; G = G_; c = c_; ntk = K_ / BK; }
    __host__ __device__ bool next(int i, Unit& u) const {
        const long L = (long)i * G + c; if (L >= nwg) return false;
        int wgid = (int)L; { const int q = nwg / NXCD, r = nwg % NXCD, xcd = wgid % NXCD, off = wgid / NXCD; wgid = (xcd < r ? xcd * (q + 1) : r * (q + 1) + (xcd - r) * q) + off; }
        const int nig = WGM * nN, gid = wgid / nig, fm = gid * WGM, gsz = (nM - fm) < WGM ? (nM - fm) : WGM;
        u.pm = fm + ((wgid % nig) % gsz); u.pn = (wgid % nig) / gsz; u.kt0 = 0; u.ntk = ntk; u.part = 0; return true;
    }
    __device__ __forceinline__ void a_ready(const Unit&) const {}
    __device__ __forceinline__ void done(const Unit&) const {}
};

__device__ __forceinline__ unsigned cvt_pk_bf16(float lo, float hi) { unsigned r; asm volatile("v_cvt_pk_bf16_f32 %0, %1, %2" : "=v"(r) : "v"(lo), "v"(hi)); return r; }
typedef float f32x2 __attribute__((ext_vector_type(2)));
template <int ACT  > struct EpiBf16 {
    static constexpr bool PERM = true, AFTER_DRAIN = false; static_assert(ACT == 0, "EpiBf16: ACT is 0");
    bf16_t* O; int ldc; const float* bias; int split_cols; size_t split_stride; float scale0;
    __device__ __forceinline__ void operator()(const f32x4 (&acc)[2][2][4][2], const Unit& u, int wr, int wc, int fr, int fq) const {
        const int row0 = u.pm * BM + wr * 64 + fr; int colt = u.pn * BM; bf16_t* base = O;
        float sc = 1.f; if (split_cols) { const int t = colt / split_cols; base += (size_t)t * split_stride; colt -= t * split_cols; if (t == 0) sc = scale0; }
        const int col0 = colt + wc * 32 + 8 * fq, bcol0 = u.pn * BM + wc * 32 + 8 * fq;
        f32x4 bv[2][2];
#pragma unroll
        for (int bj = 0; bj < 2; ++bj)
#pragma unroll
            for (int n = 0; n < 2; ++n) bv[bj][n] = bias ? *(const f32x4*)(bias + bcol0 + bj * HALF + 4 * n) : (f32x4){0.f, 0.f, 0.f, 0.f};
#pragma unroll
        for (int ai = 0; ai < 2; ++ai)
#pragma unroll
            for (int m = 0; m < 4; ++m) { bf16_t* rowp = base + (size_t)(row0 + ai * HALF + m * 16) * ldc + col0;
#pragma unroll
                for (int bj = 0; bj < 2; ++bj) { f32x4 v0 = acc[ai][bj][m][0] + bv[bj][0], v1 = acc[ai][bj][m][1] + bv[bj][1];
                    v0 = v0 * sc; v1 = v1 * sc; u32x4 w; w.x = cvt_pk_bf16(v0[0], v0[1]); w.y = cvt_pk_bf16(v0[2], v0[3]); w.z = cvt_pk_bf16(v1[0], v1[1]); w.w = cvt_pk_bf16(v1[2], v1[3]);
                    if (!(ldc == 2304 && col0 + bj * HALF >= 2080) && !(ldc == 1536 && u.pn < 3 && wc == 3)) *(u32x4*)(rowp + bj * HALF) = w; } }
    }
};
template <class Epi, class Sched, bool ALIGN_EPI = false, bool SP2 = false>
__device__ __forceinline__ void gemm_phase(PG8_LAS unsigned char* lds, const Gemm g, const Sched& S, const Epi& E, int tid_) {
    asm volatile("" : "+v"(tid_));
    const int tid = tid_, wid = __builtin_amdgcn_readfirstlane(tid >> 6), lane = tid & 63, wr = wid >> 2, wc = wid & 3, fr = lane & 15, fq = lane >> 4;
    const int K = g.K; int nt;
    unsigned voffA[2], voffB[2];
#pragma unroll
    for (int i = 0; i < 2; ++i) { int R, C; stage_rc(tid * 16 + i * 8192, R, C); const int Rb = Epi::PERM ? ((R & ~31) + perm32(R & 31)) : R;
        voffA[i] = (unsigned)(R * K + C) * 2u; voffB[i] = (unsigned)(Rb * K + C) * 2u; }
    const size_t kstep = (size_t)(BK * 2);
    const size_t hstep = (size_t)HALF * K * 2;
    const size_t tstep = 2 * hstep;
    const unsigned ldsw = (unsigned)wid * 1024u;
    const int aoff = lds_byte(wr * 64 + fr, fq * 8), boff = lds_byte(wc * 32 + fr, fq * 8);
#define PG8_SA(b, h) (((b) * 2 + (h)) * HTB)
#define PG8_SB(b, h) ((4 + (b) * 2 + (h)) * HTB)
#define PG8_STAGE(bufoff, gbase, voff) do { _Pragma("unroll") for (int _i = 0; _i < 2; ++_i) \
        __builtin_amdgcn_global_load_lds((const unsigned*)((const char*)(gbase) + (voff)[_i]), (PG8_LAS unsigned*)(lds + (bufoff) + ldsw + _i * 8192), 16, 0, 0); } while (0)
#define PG8_LDA(dst, b, h) do { _Pragma("unroll") for (int m = 0; m < 4; ++m) _Pragma("unroll") for (int k = 0; k < 2; ++k) dst[m][k] = *(const PG8_LAS bf16x8*)(lds + PG8_SA(b, h) + aoff + m * 2048 + k * 1024); } while (0)
#define PG8_LDB(dst, b, h) do { _Pragma("unroll") for (int n = 0; n < 2; ++n) _Pragma("unroll") for (int k = 0; k < 2; ++k) dst[n][k] = *(const PG8_LAS bf16x8*)(lds + PG8_SB(b, h) + boff + n * 2048 + k * 1024); } while (0)
#define PG8_MMA(ai, bj, At, Bt) do { __builtin_amdgcn_s_setprio(1); _Pragma("unroll") for (int m = 0; m < 4; ++m) _Pragma("unroll") for (int n = 0; n < 2; ++n) _Pragma("unroll") for (int k = 0; k < 2; ++k) \
        acc[ai][bj][m][n] = __builtin_amdgcn_mfma_f32_16x16x32_bf16(Bt[n][k], At[m][k], acc[ai][bj][m][n], 0, 0, 0); __builtin_amdgcn_s_setprio(0); } while (0)
#define PG8_WAIT_V(n) asm volatile("s_waitcnt vmcnt(" #n ")" ::: "memory")
#define PG8_WAIT_L(n) asm volatile("s_waitcnt lgkmcnt(" #n ")" ::: "memory")
#define PG8_BAR __builtin_amdgcn_s_barrier()
#define PG8_SCHED __builtin_amdgcn_sched_barrier(0)
    Unit cur, nxt; int ui = 0;
    if (!S.next(0, cur)) return;
    f32x4 acc[2][2][4][2];
#pragma unroll
    for (int a = 0; a < 2; ++a)
#pragma unroll
        for (int b = 0; b < 2; ++b)
#pragma unroll
            for (int m = 0; m < 4; ++m)
#pragma unroll
                for (int n = 0; n < 2; ++n) acc[a][b][m][n] = (f32x4){0.f, 0.f, 0.f, 0.f};
    bf16x8 At[4][2], B0[2][2], B1[2][2];
    const char* cA = (const char*)g.A + (size_t)cur.pm * tstep + (size_t)cur.kt0 * kstep; const char* cB = (const char*)g.Bt + (size_t)cur.pn * tstep + (size_t)cur.kt0 * kstep; nt = cur.ntk;
    S.a_ready(cur);
    if constexpr (SP2) {
        PG8_STAGE(PG8_SB(0, 0), cB, voffB); PG8_STAGE(PG8_SB(0, 1), cB + hstep, voffB); PG8_STAGE(PG8_SA(0, 0), cA, voffA); PG8_STAGE(PG8_SA(0, 1), cA + hstep, voffA);
        if (wr == 1) PG8_BAR;
        PG8_WAIT_V(2); PG8_BAR;
        PG8_STAGE(PG8_SB(1, 0), cB + kstep, voffB); PG8_STAGE(PG8_SA(1, 0), cA + kstep, voffA); PG8_STAGE(PG8_SB(1, 1), cB + hstep + kstep, voffB);
        PG8_WAIT_V(6); PG8_BAR;
    } else {
        PG8_STAGE(PG8_SB(0, 0), cB, voffB); PG8_STAGE(PG8_SA(0, 0), cA, voffA); PG8_STAGE(PG8_SB(0, 1), cB + hstep, voffB); PG8_STAGE(PG8_SA(0, 1), cA + hstep, voffA);
        if (wr == 1) PG8_BAR;
        PG8_WAIT_V(4); PG8_BAR;
        PG8_STAGE(PG8_SB(1, 0), cB + kstep, voffB); PG8_STAGE(PG8_SA(1, 0), cA + kstep, voffA); PG8_STAGE(PG8_SB(1, 1), cB + hstep + kstep, voffB);
        PG8_WAIT_V(6); PG8_BAR;
    }
    for (;;) {
        const bool has_next = S.next(ui + 1, nxt);
        const char* nA = has_next ? (const char*)g.A + (size_t)nxt.pm * tstep + (size_t)nxt.kt0 * kstep : cA; const char* nB = has_next ? (const char*)g.Bt + (size_t)nxt.pn * tstep + (size_t)nxt.kt0 * kstep : cB;
        for (int t = 0; t < nt; t += 2) {
            const bool last = (t == nt - 2);
            const char* a1 = cA + (size_t)(t + 1) * kstep;
            const char* a2 = last ? nA : cA + (size_t)(t + 2) * kstep; const char* b2 = last ? nB : cB + (size_t)(t + 2) * kstep;
            const char* a3 = a2 + kstep; const char* b3 = b2 + kstep;
            if (last && has_next) S.a_ready(nxt);
            if constexpr (SP2) {
            PG8_LDB(B0, 0, 0); PG8_LDB(B1, 0, 1); PG8_SCHED; PG8_LDA(At, 0, 0); PG8_STAGE(PG8_SA(1, 1), a1 + hstep, voffA);
            PG8_WAIT_V(8); PG8_WAIT_L(0); PG8_BAR; PG8_MMA(0, 0, At, B0); PG8_MMA(0, 1, At, B1); PG8_BAR; PG8_SCHED;
            PG8_LDA(At, 0, 1); PG8_STAGE(PG8_SB(0, 0), b2, voffB); PG8_STAGE(PG8_SB(0, 1), b2 + hstep, voffB); PG8_STAGE(PG8_SA(0, 0), a2, voffA);
            PG8_WAIT_V(8); PG8_WAIT_L(0); PG8_BAR; PG8_MMA(1, 0, At, B0); PG8_MMA(1, 1, At, B1); PG8_BAR; PG8_SCHED;
            PG8_LDB(B0, 1, 0); PG8_LDB(B1, 1, 1); PG8_SCHED; PG8_LDA(At, 1, 0); PG8_STAGE(PG8_SA(0, 1), a2 + hstep, voffA);
            PG8_WAIT_V(8); PG8_WAIT_L(0); PG8_BAR; PG8_MMA(0, 0, At, B0); PG8_MMA(0, 1, At, B1); PG8_BAR; PG8_SCHED;
            PG8_LDA(At, 1, 1); PG8_STAGE(PG8_SB(1, 0), b3, voffB); PG8_STAGE(PG8_SB(1, 1), b3 + hstep, voffB); PG8_STAGE(PG8_SA(1, 0), a3, voffA);
            PG8_WAIT_V(8); PG8_WAIT_L(0); PG8_BAR; PG8_MMA(1, 0, At, B0); PG8_MMA(1, 1, At, B1); PG8_BAR; PG8_SCHED;
            } else {
            PG8_LDB(B0, 0, 0); PG8_SCHED; PG8_LDA(At, 0, 0); PG8_STAGE(PG8_SA(1, 1), a1 + hstep, voffA);
            PG8_WAIT_L(8); PG8_BAR; PG8_WAIT_L(0); PG8_MMA(0, 0, At, B0); PG8_BAR; PG8_SCHED;
            PG8_LDB(B1, 0, 1); PG8_STAGE(PG8_SB(0, 0), b2, voffB);
            PG8_BAR; PG8_WAIT_L(0); PG8_MMA(0, 1, At, B1); PG8_BAR;
            PG8_LDA(At, 0, 1); PG8_STAGE(PG8_SA(0, 0), a2, voffA);
            PG8_BAR; PG8_WAIT_L(0); PG8_MMA(1, 0, At, B0); PG8_BAR; PG8_SCHED;
            PG8_STAGE(PG8_SB(0, 1), b2 + hstep, voffB);
            PG8_WAIT_V(6); PG8_BAR; PG8_MMA(1, 1, At, B1); PG8_BAR;
            PG8_LDB(B0, 1, 0); PG8_SCHED; PG8_LDA(At, 1, 0); PG8_STAGE(PG8_SA(0, 1), a2 + hstep, voffA);
            PG8_WAIT_L(8); PG8_BAR; PG8_WAIT_L(0); PG8_MMA(0, 0, At, B0); PG8_BAR; PG8_SCHED;
            PG8_LDB(B1, 1, 1); PG8_STAGE(PG8_SB(1, 0), b3, voffB);
            PG8_BAR; PG8_WAIT_L(0); PG8_MMA(0, 1, At, B1); PG8_BAR;
            PG8_LDA(At, 1, 1); PG8_STAGE(PG8_SA(1, 0), a3, voffA);
            PG8_BAR; PG8_WAIT_L(0); PG8_MMA(1, 0, At, B0); PG8_BAR; PG8_SCHED;
            PG8_STAGE(PG8_SB(1, 1), b3 + hstep, voffB);
            PG8_WAIT_V(6); PG8_BAR; PG8_MMA(1, 1, At, B1); PG8_BAR;
            }
        }
        if constexpr (ALIGN_EPI) { if (wr == 0) PG8_BAR; }
        if constexpr (!Epi::AFTER_DRAIN) { E(acc, cur, wr, wc, fr, fq); S.done(cur); }
        if (!has_next) break;
#pragma unroll
        for (int a = 0; a < 2; ++a)
#pragma unroll
            for (int b = 0; b < 2; ++b)
#pragma unroll
                for (int m = 0; m < 4; ++m)
#pragma unroll
                    for (int n = 0; n < 2; ++n) acc[a][b][m][n] = (f32x4){0.f, 0.f, 0.f, 0.f};
        cur = nxt; cA = nA; cB = nB; nt = cur.ntk; ++ui;
        if constexpr (ALIGN_EPI) { if (wr == 1) PG8_BAR; }
    }
    PG8_WAIT_V(0);
    if constexpr (!ALIGN_EPI) { if (wr == 0) PG8_BAR; }
    PG8_BAR;
    if constexpr (Epi::AFTER_DRAIN) { E.fused(acc, cur, wr, wc, fr, fq, lds, wid, lane); S.done(cur); }
#undef PG8_SA
#undef PG8_SB
#undef PG8_STAGE
#undef PG8_LDA
#undef PG8_LDB
#undef PG8_MMA
#undef PG8_WAIT_V
#undef PG8_WAIT_L
#undef PG8_BAR
#undef PG8_SCHED
}
}

#ifndef MK_MULTI
#define MK_MULTI 0
#endif
#ifndef DBL
#define DBL 0
#endif
#ifndef EN
#define EN 0xffff
#endif
#define LAS __attribute__((address_space(3)))
#define GAS __attribute__((address_space(1)))
typedef unsigned short bf16;
typedef float f32x4 __attribute__((ext_vector_type(4)));
typedef unsigned u32x4 __attribute__((ext_vector_type(4)));
typedef unsigned u32x2 __attribute__((ext_vector_type(2)));

constexpr int DM = 1024, NB = 8, SEQ = 2048, DEPTH = 4, CTXL = 256, DFF = 2816, NMOD = 9;
constexpr int MLAT = NB * SEQ, MCTX = NB * CTXL, MTOT = MLAT + MCTX;
constexpr int LKV = CTXL + SEQ;
constexpr int INC = 2080, INP = 2304;
constexpr int PC_K = 384, PC_V = 512, PC_X = 640, PC_BG = 896, PC_CG = 1152, PC_CQ = 1408, PC_CKV = 1792, PC_KR = 2048;
constexpr int NGU = 2 * DFF;
constexpr float EPS = 1e-6f;
constexpr float LOG2E = 1.4426950408889634f;
constexpr float QSCALE_A = 0.125f * LOG2E;
constexpr float QSCALE_M = 0.10206207261596577f * LOG2E;
constexpr float L2THETA = 13.287712379549449f;

constexpr size_t MiB = 1u << 20;
constexpr size_t WS_MOD = 0;
constexpr size_t WS_CTL = 1536 * 1024, CTL_BYTES = 16384;
constexpr size_t WS_WGU = 2 * MiB;
constexpr size_t SZ_WGU = (size_t)NGU * DM * 2;
constexpr size_t WS_WD = WS_WGU + 8 * SZ_WGU;
constexpr size_t SZ_WD = (size_t)DM * DFF * 2;
constexpr size_t WS_WIN = WS_WD + 8 * SZ_WD;
constexpr size_t SZ_WIN = (size_t)INP * DM * 2;
constexpr size_t WS_WOUT = WS_WIN + 4 * SZ_WIN;
constexpr size_t SZ_WOUT = (size_t)DM * DM * 2;
constexpr size_t WS_WUP = WS_WOUT + 4 * SZ_WOUT;
constexpr size_t SZ_WUP = (size_t)1536 * 640 * 2;
constexpr size_t WS_X = WS_WUP + 4 * SZ_WUP;
constexpr size_t WS_H = WS_X + (size_t)MTOT * DM * 4;
constexpr size_t WS_R = WS_H + (size_t)MTOT * DM * 2;
constexpr size_t WS_GU = WS_R;
constexpr size_t WS_P = WS_R;
constexpr size_t WS_QKVR = WS_R;
constexpr size_t WS_CQKV = WS_P + (size_t)MTOT * INP * 2;
constexpr size_t WS_QA = WS_CQKV + (size_t)MTOT * 640 * 2;
constexpr size_t WS_PART = WS_QA;
constexpr size_t WS_KA = WS_QA + (size_t)NB * 6 * LKV * 64 * 2;
constexpr size_t WS_VA = WS_KA + (size_t)NB * 2 * LKV * 64 * 2;
constexpr size_t WS_QM = WS_VA + (size_t)NB * 2 * LKV * 64 * 2;
constexpr size_t WS_KM = WS_QM + (size_t)NB * 6 * LKV * 96 * 2;
constexpr size_t WS_VM = WS_KM + (size_t)NB * 6 * LKV * 96 * 2;
constexpr size_t WS_YC = WS_VM + (size_t)NB * 6 * LKV * 64 * 2;
constexpr size_t WS_END = WS_YC + (size_t)MTOT * DM * 2;
static_assert(WS_QKVR + (size_t)MTOT * 1536 * 2 <= WS_CQKV, "QKVR overlays P");
static_assert(WS_GU + (size_t)MTOT * DFF * 2 <= WS_END, "GU inside the shared region");
static_assert(WS_X % 256 == 0 && WS_R % 256 == 0 && WS_QA % 256 == 0 && WS_YC % 256 == 0, "alignment");

#ifndef SPLITS
#define SPLITS 4
#endif
static_assert(WS_PART >= WS_GU + (size_t)MTOT * DFF * 2 && WS_PART + (size_t)SPLITS * MCTX * DM * 4 <= WS_YC, "split-K parts overlay QA..VM (all dead while the parts are live), clear of GU and YC");
constexpr int LDS_BYTES = 147456;
constexpr int NPHASE = 1 + 13 * DEPTH;

__device__ __forceinline__ float shx(float v, int o, int lane) { return __builtin_bit_cast(float, __builtin_amdgcn_ds_bpermute((lane ^ o) << 2, __builtin_bit_cast(int, v))); }
__device__ __forceinline__ float dpp_x1(float v) { return __builtin_bit_cast(float, __builtin_amdgcn_update_dpp(0, __builtin_bit_cast(int, v), 0xB1, 0xF, 0xF, false)); }
__device__ __forceinline__ float dpp_x2(float v) { return __builtin_bit_cast(float, __builtin_amdgcn_update_dpp(0, __builtin_bit_cast(int, v), 0x4E, 0xF, 0xF, false)); }
__device__ __forceinline__ float dpp_hm(float v) { return __builtin_bit_cast(float, __builtin_amdgcn_update_dpp(0, __builtin_bit_cast(int, v), 0x141, 0xF, 0xF, false)); }
__device__ __forceinline__ float wave_sum(float v, int lane) {
#pragma unroll
    for (int o = 1; o < 64; o <<= 1) v += shx(v, o, lane);
    return v;
}
__device__ __forceinline__ float wave_max(float v, int lane) {
#pragma unroll
    for (int o = 1; o < 64; o <<= 1) v = fmaxf(v, shx(v, o, lane));
    return v;
}
__device__ __forceinline__ unsigned f2bf(float f) { unsigned u = __builtin_bit_cast(unsigned, f); return (u + 0x7fffu + ((u >> 16) & 1u)) >> 16; }
__device__ __forceinline__ unsigned pk2(float lo, float hi) { return f2bf(lo) | (f2bf(hi) << 16); }
__device__ __forceinline__ float bf2f(bf16 b) { return __builtin_bit_cast(float, (unsigned)b << 16); }
__device__ __forceinline__ float silu_f(float g) { return g * __builtin_amdgcn_rcpf(1.0f + __expf(-g)); }

template <class T> __device__ __forceinline__ T* uptr(T* p) {
    unsigned long long v = (unsigned long long)p;
    const unsigned lo = __builtin_amdgcn_readfirstlane((unsigned)v), hi = __builtin_amdgcn_readfirstlane((unsigned)(v >> 32));
    return (T*)(((unsigned long long)hi << 32) | lo);
}
namespace pg8 {
struct EpiSwiGLU {
    static constexpr bool PERM = true, AFTER_DRAIN = false;
    bf16_t* O;
    __device__ __forceinline__ void operator()(const f32x4 (&acc)[2][2][4][2], const Unit& u, int wr, int wc, int fr, int fq) const {
        const int row0 = u.pm * BM + wr * 64 + fr, col0 = u.pn * HALF + wc * 32 + 8 * fq;
#pragma unroll
        for (int ai = 0; ai < 2; ++ai)
#pragma unroll
            for (int m = 0; m < 4; ++m) {
                bf16_t* rowp = O + (size_t)(row0 + ai * HALF + m * 16) * DFF + col0;
                const f32x4 g0 = acc[ai][0][m][0], g1 = acc[ai][0][m][1], u0 = acc[ai][1][m][0], u1 = acc[ai][1][m][1];
                u32x4 w;
                w.x = cvt_pk_bf16(silu_f(g0[0]) * u0[0], silu_f(g0[1]) * u0[1]);
                w.y = cvt_pk_bf16(silu_f(g0[2]) * u0[2], silu_f(g0[3]) * u0[3]);
                w.z = cvt_pk_bf16(silu_f(g1[0]) * u1[0], silu_f(g1[1]) * u1[1]);
                w.w = cvt_pk_bf16(silu_f(g1[2]) * u1[2], silu_f(g1[3]) * u1[3]);
                *(u32x4*)rowp = w;
            }
    }
};
struct EpiResid {
    static constexpr bool PERM = true, AFTER_DRAIN = false;
    const bf16_t* xin; bf16_t* xout; float* fout; const float* modl; int kmod; float coef;
    __device__ __forceinline__ void operator()(const f32x4 (&acc)[2][2][4][2], const Unit& u, int wr, int wc, int fr, int fq) const {
        const int rowt = u.pm * BM; const int mr = rowt < MLAT ? (rowt >> 11) : 8;
        const float* gv = modl + (size_t)mr * (NMOD * DM) + kmod * DM;
        const int col0 = u.pn * BM + wc * 32 + 8 * fq;
        f32x4 g[2][2];
#pragma unroll
        for (int bj = 0; bj < 2; ++bj)
#pragma unroll
            for (int n = 0; n < 2; ++n) g[bj][n] = *(const f32x4*)(gv + col0 + bj * HALF + 4 * n) * coef;
        float* part = (float*)((char*)const_cast<bf16_t*>(xin) + ((long long)WS_PART - (long long)WS_X));
        if (u.ntk != (kmod == 5 ? DM / 64 : DFF / 64)) {
#pragma unroll
            for (int ai = 0; ai < 2; ++ai)
#pragma unroll
                for (int m = 0; m < 4; ++m) {
                    bf16_t* pp = (bf16_t*)part + ((size_t)u.part * MCTX + (rowt - MLAT + ai * HALF + wr * 64 + m * 16 + fr)) * DM + col0;
#pragma unroll
                    for (int bj = 0; bj < 2; ++bj) { const f32x4 y0 = g[bj][0] * acc[ai][bj][m][0], y1 = g[bj][1] * acc[ai][bj][m][1];
                        u32x4 o; o.x = cvt_pk_bf16(y0[0], y0[1]); o.y = cvt_pk_bf16(y0[2], y0[3]); o.z = cvt_pk_bf16(y1[0], y1[1]); o.w = cvt_pk_bf16(y1[2], y1[3]); *(u32x4*)(pp + bj * HALF) = o; }
                }
            return;
        }
#pragma unroll
        for (int ai = 0; ai < 2; ++ai) {
            u32x4 xb[4][2];
#pragma unroll
            for (int m = 0; m < 4; ++m)
#pragma unroll
                for (int bj = 0; bj < 2; ++bj) xb[m][bj] = *(const u32x4*)(xin + (size_t)(rowt + ai * HALF + wr * 64 + m * 16 + fr) * DM + col0 + bj * HALF);
#pragma unroll
            for (int m = 0; m < 4; ++m) {
                const size_t off = (size_t)(rowt + ai * HALF + wr * 64 + m * 16 + fr) * DM + col0;
#pragma unroll
                for (int bj = 0; bj < 2; ++bj) {
                    const u32x4 x = xb[m][bj];
                    const f32x4 x0 = {__builtin_bit_cast(float, x.x << 16), __builtin_bit_cast(float, x.x & 0xffff0000u), __builtin_bit_cast(float, x.y << 16), __builtin_bit_cast(float, x.y & 0xffff0000u)};
                    const f32x4 x1 = {__builtin_bit_cast(float, x.z << 16), __builtin_bit_cast(float, x.z & 0xffff0000u), __builtin_bit_cast(float, x.w << 16), __builtin_bit_cast(float, x.w & 0xffff0000u)};
                    const f32x4 y0 = x0 + g[bj][0] * acc[ai][bj][m][0], y1 = x1 + g[bj][1] * acc[ai][bj][m][1];
                    if (fout) { *(f32x4*)(fout + off + bj * HALF) = y0; *(f32x4*)(fout + off + bj * HALF + 4) = y1; }
                    else { u32x4 o; o.x = cvt_pk_bf16(y0[0], y0[1]); o.y = cvt_pk_bf16(y0[2], y0[3]); o.z = cvt_pk_bf16(y1[0], y1[1]); o.w = cvt_pk_bf16(y1[2], y1[3]); *(u32x4*)(xout + off + bj * HALF) = o; }
                }
            }
            asm volatile("" ::: "memory");
        }
    }
};
struct BdOrder {
    StaticOrder base; bool bd;
    __device__ void init(int M, int N, int G_, int c_, int K_, bool bd_) { base.init(M, N, G_, c_, K_); bd = bd_; }
    __device__ bool next(int i, Unit& u) const {
        if (!base.next(i, u)) return false;
        if (bd) { if (u.pn < 3) { u.kt0 = 0; u.ntk = 6; } else { u.kt0 = 6; u.ntk = 4; } }
        return true;
    }
    __device__ __forceinline__ void a_ready(const Unit&) const {}
    __device__ __forceinline__ void done(const Unit&) const {}
};
struct LatCtxOrder {
    StaticOrder lat, all; int G, c, nlr, nseg, S, npairs; bool plain;
    __device__ void init(int M, int G_, int c_, int K_, int S_) {
        lat.init(MLAT, DM, G_, c_, K_); all.init(M, DM, G_, c_, K_); G = G_; c = c_; S = S_; npairs = K_ / (2 * BK);
        plain = (lat.nwg % G_) != 0 || M <= MLAT; nlr = lat.nwg / G_; nseg = ((M - MLAT) / BM) * 4 * S_;
    }
    __device__ bool next(int i, Unit& u) const {
        if (plain) return all.next(i, u);
        if (i < nlr) return lat.next(i, u);
        const int sidx = (i - nlr) * G + c; if (sidx >= nseg) return false;
        const int tile = sidx / S, part = sidx % S, p0 = part * npairs / S, p1 = (part + 1) * npairs / S;
        u.pm = MLAT / BM + (tile >> 2); u.pn = tile & 3; u.kt0 = 2 * p0; u.ntk = 2 * (p1 - p0); u.part = part; return true;
    }
    __device__ __forceinline__ void a_ready(const Unit&) const {}
    __device__ __forceinline__ void done(const Unit&) const {}
};
}


typedef short bf16x8 __attribute__((ext_vector_type(8)));
typedef short s16x4 __attribute__((ext_vector_type(4)));
typedef float f32x16 __attribute__((ext_vector_type(16)));
__device__ __forceinline__ int crow(int r, int hi) { return (r & 3) + 8 * (r >> 2) + 4 * hi; }
typedef float f32x2_t __attribute__((ext_vector_type(2))); typedef __bf16 bf16x2_t __attribute__((ext_vector_type(2)));
__device__ __forceinline__ unsigned cvtpk(float lo, float hi) { f32x2_t v = {lo, hi}; bf16x2_t b = __builtin_convertvector(v, bf16x2_t); return __builtin_bit_cast(unsigned, b); }
constexpr int AT_KBUF = 26624, AT_VBUF = 16384, AT_VOFF = 2 * AT_KBUF, AT_WSF = AT_VOFF + 2 * AT_VBUF;
template <int DK>
__device__ __forceinline__ void attn_unit(LAS unsigned char* lds, const GAS bf16* Qp, const GAS bf16* Kp, const GAS bf16* Vp, GAS bf16* Yp, int b, int j, int nkeys, int tid, int lane, int wave) {
    constexpr int KSTR = DK * 2 + 16, ND = DK / 16, CPR = DK / 8, NKC = CPR / 4;
    const int r32 = lane & 31, hi = lane >> 5;
    bf16x8 qr[ND];
    { const GAS bf16* Qw = Qp + (size_t)(256 * j + wave * 32 + r32) * DK + hi * 8;
#pragma unroll
      for (int d0 = 0; d0 < ND; ++d0) qr[d0] = *(const GAS bf16x8*)(Qw + d0 * 16); }
    int koff[NKC], voff[2];
#pragma unroll
    for (int i = 0; i < NKC; ++i) { const int kc = tid + 512 * i; koff[i] = (kc / CPR) * KSTR + (kc % CPR) * 16; }
#pragma unroll
    for (int i = 0; i < 2; ++i) { const int vc = tid + 512 * i, vrow = vc >> 3, vch = vc & 7; voff[i] = AT_VOFF + (vch >> 2) * 8192 + (vrow >> 4) * 1024 + (vrow & 15) * 64 + (vch & 3) * 16; }
    const int NT = nkeys >> 7;
    u32x4 kreg[NKC], vreg[2];
#define AT_LOAD(t) do { const GAS u32x4* Kg_ = (const GAS u32x4*)(Kp + (size_t)(t) * 128 * DK); const GAS u32x4* Vg_ = (const GAS u32x4*)(Vp + (size_t)(t) * 128 * 64); \
        _Pragma("unroll") for (int i_ = 0; i_ < NKC; ++i_) kreg[i_] = Kg_[tid + 512 * i_]; vreg[0] = Vg_[tid]; vreg[1] = Vg_[tid + 512]; } while (0)
#define AT_STORE(bf_) do { LAS unsigned char* nb_ = lds + (bf_) * AT_KBUF; _Pragma("unroll") for (int i_ = 0; i_ < NKC; ++i_) *(LAS u32x4*)(nb_ + koff[i_]) = kreg[i_]; \
        *(LAS u32x4*)(lds + (bf_) * AT_VBUF + voff[0]) = vreg[0]; *(LAS u32x4*)(lds + (bf_) * AT_VBUF + voff[1]) = vreg[1]; } while (0)
    AT_LOAD(0); AT_STORE(0);
    if (NT > 1) AT_LOAD(1);
    __syncthreads();
    LAS float* wsf = (LAS float*)(lds + AT_WSF) + wave * 32;
    float mhat = 0.f;
    f32x16 o0, o1, ol, negm;
#pragma unroll
    for (int r = 0; r < 16; ++r) { o0[r] = 0.f; o1[r] = 0.f; ol[r] = 0.f; negm[r] = 0.f; }
    const bf16x8 ones = {0x3F80, 0x3F80, 0x3F80, 0x3F80, 0x3F80, 0x3F80, 0x3F80, 0x3F80};
    const int kfo = r32 * KSTR + hi * 16;
    const int vfo = AT_VOFF + (4 * hi + ((lane & 15) >> 2)) * 64 + ((lane >> 4) & 1) * 32 + (lane & 3) * 8;
    for (int t = 0; t < NT; ++t) {
        const int cur = t & 1;
        f32x16 p[4];
        { LAS unsigned char* kb = lds + cur * AT_KBUF + kfo;
          bf16x8 ka[2][4];
#pragma unroll
          for (int q4 = 0; q4 < 4; ++q4) ka[0][q4] = *(LAS bf16x8*)(kb + q4 * 32 * KSTR);
#pragma unroll
          for (int d0 = 0; d0 < ND; ++d0) {
              if (d0 + 1 < ND) {
#pragma unroll
                  for (int q4 = 0; q4 < 4; ++q4) ka[(d0 + 1) & 1][q4] = *(LAS bf16x8*)(kb + q4 * 32 * KSTR + (d0 + 1) * 32);
              }
#pragma unroll
              for (int q4 = 0; q4 < 4; ++q4) p[q4] = __builtin_amdgcn_mfma_f32_32x32x16_bf16(ka[d0 & 1][q4], qr[d0], d0 == 0 ? negm : p[q4], 0, 0, 0);
              if (d0 == 0) { if (t + 1 < NT) AT_STORE(cur ^ 1); if (t + 2 < NT) AT_LOAD(t + 2); }
              __builtin_amdgcn_sched_barrier(0);
          } }
        float rma = fmaxf(p[0][0], p[1][0]), rmb = fmaxf(p[2][0], p[3][0]);
#pragma unroll
        for (int r = 1; r < 16; ++r) { rma = fmaxf(fmaxf(rma, p[0][r]), p[1][r]); rmb = fmaxf(fmaxf(rmb, p[2][r]), p[3][r]); }
        float rm = fmaxf(rma, rmb);
        { const unsigned ru_ = __builtin_bit_cast(unsigned, rm); auto rr_ = __builtin_amdgcn_permlane32_swap(ru_, ru_, false, false);
          rm = fmaxf(__builtin_bit_cast(float, (unsigned)rr_[0]), __builtin_bit_cast(float, (unsigned)rr_[1])); }
        if (t == 0 || __any(rm > 8.0f)) {
            const float dl = (t == 0) ? rm : fmaxf(rm, 0.f), f = __builtin_amdgcn_exp2f(-dl);
            mhat += dl;
#pragma unroll
            for (int r = 0; r < 16; ++r) { p[0][r] -= dl; p[1][r] -= dl; p[2][r] -= dl; p[3][r] -= dl; negm[r] = -mhat; }
            if (hi == 0) wsf[r32] = f;
            asm volatile("s_waitcnt lgkmcnt(0)" ::: "memory");
#pragma unroll
            for (int r = 0; r < 16; ++r) { const float fr = wsf[crow(r, hi)]; o0[r] *= fr; o1[r] *= fr; ol[r] *= fr; }
            asm volatile("s_waitcnt lgkmcnt(0)" ::: "memory");
        }
        u32x4 pw[8];
        { LAS unsigned char* vb = lds + cur * AT_VBUF + vfo;
#define AT_VF(d0, ks) ({ const s16x4 lo_ = __builtin_bit_cast(s16x4, __builtin_amdgcn_ds_read_tr16_b64_v4i16((LAS s16x4*)(vb + (d0) * 8192 + (ks) * 1024))); \
                         const s16x4 hi_ = __builtin_bit_cast(s16x4, __builtin_amdgcn_ds_read_tr16_b64_v4i16((LAS s16x4*)(vb + (d0) * 8192 + (ks) * 1024 + 512))); \
                         (bf16x8){lo_[0], lo_[1], lo_[2], lo_[3], hi_[0], hi_[1], hi_[2], hi_[3]}; })
#define AT_EXPQ(q4) do { _Pragma("unroll") for (int r = 0; r < 16; ++r) p[q4][r] = __builtin_amdgcn_exp2f(p[q4][r]); \
            pw[2 * (q4)] = (u32x4){cvtpk(p[q4][0], p[q4][1]), cvtpk(p[q4][2], p[q4][3]), cvtpk(p[q4][4], p[q4][5]), cvtpk(p[q4][6], p[q4][7])}; \
            pw[2 * (q4) + 1] = (u32x4){cvtpk(p[q4][8], p[q4][9]), cvtpk(p[q4][10], p[q4][11]), cvtpk(p[q4][12], p[q4][13]), cvtpk(p[q4][14], p[q4][15])}; } while (0)
#define AT_PVK(ks, VF) do { o0 = __builtin_amdgcn_mfma_f32_32x32x16_bf16(__builtin_bit_cast(bf16x8, pw[ks]), VF[0], o0, 0, 0, 0); \
            o1 = __builtin_amdgcn_mfma_f32_32x32x16_bf16(__builtin_bit_cast(bf16x8, pw[ks]), VF[1], o1, 0, 0, 0); \
            ol = __builtin_amdgcn_mfma_f32_32x32x16_bf16(__builtin_bit_cast(bf16x8, pw[ks]), ones, ol, 0, 0, 0); } while (0)
          bf16x8 vfa[2], vfb[2];
          vfa[0] = AT_VF(0, 0); vfa[1] = AT_VF(1, 0);
          AT_EXPQ(0);
          __builtin_amdgcn_sched_barrier(0);
#pragma unroll
          for (int q4 = 0; q4 < 4; ++q4) {
              vfb[0] = AT_VF(0, 2 * q4 + 1); vfb[1] = AT_VF(1, 2 * q4 + 1);
              AT_PVK(2 * q4, vfa);
              if (q4 + 1 < 4) { AT_EXPQ(q4 + 1); vfa[0] = AT_VF(0, 2 * q4 + 2); vfa[1] = AT_VF(1, 2 * q4 + 2); }
              AT_PVK(2 * q4 + 1, vfb);
              __builtin_amdgcn_sched_barrier(0);
          }
#undef AT_EXPQ
#undef AT_PVK
#undef AT_VF
        }
        __syncthreads();
    }
#undef AT_LOAD
#undef AT_STORE
    const int pos0 = 256 * j + wave * 32;
#pragma unroll
    for (int r = 0; r < 16; ++r) {
        const int qq = crow(r, hi); const float inv = __builtin_amdgcn_rcpf(ol[r]); const int pos = pos0 + qq;
        const int row = (j == 0) ? MLAT + b * CTXL + pos : b * SEQ + pos - CTXL;
        GAS bf16* yp = Yp + (size_t)row * DM + r32;
        yp[0] = (bf16)f2bf(o0[r] * inv); yp[32] = (bf16)f2bf(o1[r] * inv);
    }
    asm volatile("s_waitcnt lgkmcnt(0)" ::: "memory");
    __syncthreads();
}

#define XB_TMO      128
#define XB_XCNT(j)  (256  + 64 * (j))
#define XB_XSUB(j)  (1280 + 64 * (j))
#define XB_XGEN(j)  (2304 + 64 * (j))
#define XB_TOP      3328
#define XB_TOPGEN   3392
#define XCD_BAR_WORDS 3456
#define XB_SPIN_CAP (1u << 18)

__device__ __forceinline__ unsigned xb_ld(unsigned* p)              { return __hip_atomic_load(p, __ATOMIC_RELAXED, __HIP_MEMORY_SCOPE_AGENT); }
__device__ __forceinline__ unsigned xb_add(unsigned* p, unsigned v) { return __hip_atomic_fetch_add(p, v, __ATOMIC_RELAXED, __HIP_MEMORY_SCOPE_AGENT); }
__device__ __forceinline__ unsigned xb_xcc_id() { return (unsigned)__builtin_amdgcn_s_getreg((3 << 11) | 20) & 0xFu; }
#define XB_SPIN(cond, bar) do { unsigned _sp = 0; while (cond) { __builtin_amdgcn_s_sleep(1); \
    if ((++_sp & 255u) == 0u) { if (xb_ld(&(bar)[XB_TMO])) break; if (_sp > XB_SPIN_CAP) { atomicAdd(&(bar)[XB_TMO], 1u); break; } } } } while (0)

struct XcdBarrier {
    unsigned* bar; unsigned x;
    volatile LAS unsigned* st;
};

__device__ __forceinline__ XcdBarrier xcd_barrier_post(unsigned* bar, volatile LAS unsigned* st) {
    XcdBarrier b; b.bar = bar; b.x = xb_xcc_id(); b.st = st;
    if (threadIdx.x == 0) (void)xb_add(&bar[XB_XCNT(b.x)], 1u);
    return b;
}
__device__ __forceinline__ void xcd_barrier_complete(unsigned* bar, unsigned x, unsigned& nloc, unsigned& nx) {
    const unsigned G = gridDim.x * gridDim.y * gridDim.z;
    unsigned sum, cnt, mine, sp = 0u;
    for (;;) {
        sum = 0u; cnt = 0u; mine = 0u;
#pragma unroll
        for (unsigned j = 0; j < 16; ++j) { const unsigned c = xb_ld(&bar[XB_XCNT(j)]); sum += c; cnt += (c > 0u) ? 1u : 0u; mine = (j == x) ? c : mine; }
        if (sum == G) break;
        __builtin_amdgcn_s_sleep(1);
        if ((++sp & 255u) == 0u) { if (xb_ld(&bar[XB_TMO])) break; if (sp > XB_SPIN_CAP) { atomicAdd(&bar[XB_TMO], 1u); break; } }
    }
    nloc = mine > 0u ? mine : 1u; nx = cnt > 0u ? cnt : 1u;
}

__device__ __forceinline__ void xcd_barrier(const XcdBarrier& b) {
    asm volatile("s_waitcnt vmcnt(0)" ::: "memory");
    __syncthreads();
    if (threadIdx.x == 0) {
        unsigned* bar = b.bar;
        __builtin_amdgcn_s_waitcnt(0);
        unsigned nloc = b.st[0], nx = b.st[1];
        if (nloc == 0u) { xcd_barrier_complete(bar, b.x, nloc, nx); b.st[0] = nloc; b.st[1] = nx; }
        const unsigned old = xb_add(&bar[XB_XSUB(b.x)], 1u);
        const unsigned gen = old / nloc;
        if (old + 1u == (gen + 1u) * nloc) {
            __builtin_amdgcn_fence(__ATOMIC_RELEASE, "agent");
            asm volatile("s_waitcnt vmcnt(0)" ::: "memory");
            const unsigned og = xb_add(&bar[XB_TOP], 1u);
            const unsigned tg = og / nx;
            if (og + 1u == (tg + 1u) * nx) xb_add(&bar[XB_TOPGEN], 1u);
            else XB_SPIN(xb_ld(&bar[XB_TOPGEN]) == tg, bar);
            __builtin_amdgcn_fence(__ATOMIC_ACQUIRE, "agent");
            xb_add(&bar[XB_XGEN(b.x)], 1u);
            asm volatile("s_waitcnt vmcnt(0)" ::: "memory");
        } else {
            XB_SPIN(xb_ld(&bar[XB_XGEN(b.x)]) == gen, bar);
            __builtin_amdgcn_fence(__ATOMIC_ACQUIRE, "agent");
            asm volatile("s_waitcnt vmcnt(0)" ::: "memory");
        }
    }
    __syncthreads();
}

struct Args { const float* in[24]; float* out; unsigned char* ws; int ph_lo, ph_hi; };

__device__ __forceinline__ int drow_of(int n, int rmode) {
    return rmode == 0 ? n : (rmode == 1 ? 256 * (n >> 7) + (n & 127) : (rmode == 2 ? 256 * (n >> 7) + 128 + (n & 127) : 128 * (n / 96) + (n % 96)));
}
__device__ __forceinline__ void transpose_item(const float* Wg, int K, int N, bf16* WTg, int pitch, int rmode, LAS float* scr, int item, int lane) {
    const GAS float* W = (const GAS float*)Wg; GAS bf16* WT = (GAS bf16*)WTg;
    const int nblk = (N + 63) >> 6, kb = item / nblk, nb = item % nblk, k0 = 64 * kb, n0 = 64 * nb;
    const bool valid = n0 + lane < N;
    const GAS float* src = W + (size_t)k0 * N + n0 + lane;
    float val[64];
#pragma unroll
    for (int i = 0; i < 64; ++i) val[i] = valid ? src[(size_t)i * N] : 0.f;
#pragma unroll
    for (int i = 0; i < 64; ++i) scr[i * 65 + lane] = val[i];
    asm volatile("s_waitcnt lgkmcnt(0)" ::: "memory");
    const int c = lane & 7;
#pragma unroll
    for (int j = 0; j < 8; ++j) { const int nl = (lane >> 3) + 8 * j, n = n0 + nl; const LAS float* sp_ = scr + (8 * c) * 65 + nl;
        u32x4 o; o.x = pk2(sp_[0 * 65], sp_[1 * 65]); o.y = pk2(sp_[2 * 65], sp_[3 * 65]); o.z = pk2(sp_[4 * 65], sp_[5 * 65]); o.w = pk2(sp_[6 * 65], sp_[7 * 65]);
        if (n < N) *(GAS u32x4*)(WT + (size_t)drow_of(n, rmode) * pitch + k0 + 8 * c) = o; }
    asm volatile("s_waitcnt lgkmcnt(0)" ::: "memory");
}

__device__ __forceinline__ float rope_inv64(int i) { return exp2f(-(float)(2 * i) * (L2THETA / 32.0f)); }
__device__ __forceinline__ float rope_inv32(int i) { return exp2f(-(float)(2 * i) * (L2THETA / 16.0f)); }

constexpr int I_FF = 704, I_IN = 528, I_OUT = 256, I_UQ = 54, I_UKV = 48, I_L = 6 * I_FF + I_IN + I_OUT + I_UQ + I_UKV;
__device__ __forceinline__ void convert_item(const Args* ap, unsigned char* ws, int l, int r, LAS float* scr, int lane) {
    const float* W; bf16* WT; int K, N, pitch, rmode, idx;
    if (r < 6 * I_FF) {
        const int j = r / (3 * I_FF), r2 = r % (3 * I_FF), which = r2 / I_FF, lj = l * 2 + j; idx = r2 % I_FF;
        if (which < 2) { W = ap->in[7 + which] + (size_t)lj * DM * DFF; K = DM; N = DFF; WT = (bf16*)(ws + WS_WGU + lj * SZ_WGU); pitch = DM; rmode = 1 + which; }
        else { W = ap->in[9] + (size_t)lj * DFF * DM; K = DFF; N = DM; WT = (bf16*)(ws + WS_WD + lj * SZ_WD); pitch = DFF; rmode = 0; }
    } else {
        r -= 6 * I_FF;
        if (r < I_IN) { W = ap->in[10] + (size_t)l * DM * INC; K = DM; N = INC; WT = (bf16*)(ws + WS_WIN + l * SZ_WIN); pitch = DM; rmode = 0; idx = r; }
        else if (r < I_IN + I_OUT) { W = ap->in[11] + (size_t)l * DM * DM; K = DM; N = DM; WT = (bf16*)(ws + WS_WOUT + l * SZ_WOUT); pitch = DM; rmode = 0; idx = r - I_IN; }
        else if (r < I_IN + I_OUT + I_UQ) { W = ap->in[18] + (size_t)l * 384 * 576; K = 384; N = 576; WT = (bf16*)(ws + WS_WUP + l * SZ_WUP); pitch = 640; rmode = 3; idx = r - I_IN - I_OUT; }
        else { W = ap->in[19] + (size_t)l * 256 * 768; K = 256; N = 768; WT = (bf16*)(ws + WS_WUP + l * SZ_WUP) + (size_t)768 * 640 + 384; pitch = 640; rmode = 0; idx = r - I_IN - I_OUT - I_UQ; }
    }
    transpose_item(W, K, N, WT, pitch, rmode, scr, idx, lane);
}

__global__ void __launch_bounds__(512, 2) fwd_mega(Args args) {
    extern __shared__ __attribute__((aligned(16))) unsigned char lds[];
    cg::grid_group grid = cg::this_grid();
    LAS unsigned char* ldsl = (LAS unsigned char*)lds;

    const int ph_lo = args.ph_lo, ph_hi = args.ph_hi;
    volatile LAS unsigned* xst = (volatile LAS unsigned*)((LAS unsigned char*)lds + LDS_BYTES - 64);
    if (threadIdx.x == 0) { xst[0] = 0u; xst[1] = 0u; }
    __syncthreads();
    const XcdBarrier xbar = xcd_barrier_post((unsigned*)(args.ws + WS_CTL), xst);
    const int wave0 = __builtin_amdgcn_readfirstlane(threadIdx.x >> 6);
    const Args* ap = (const Args*)__builtin_amdgcn_kernarg_segment_ptr();
#if DBL
    bool redo = false;
#endif
    for (int ph = ph_lo; ph < ph_hi; ++ph) {
        asm volatile("" : "+s"(ap));
        ap = uptr(ap);
        int lane_ = __lane_id(); asm volatile("" : "+v"(lane_));
        const int tid = wave0 * 64 + lane_;
        int G = gridDim.x, bx = blockIdx.x; asm volatile("" : "+s"(G), "+s"(bx));
        const int lane = lane_, wave = wave0;
        const int gw = bx * 8 + wave, NGW = G * 8;
        unsigned char* ws = uptr(ap->ws);
        float* MOD = (float*)(ws + WS_MOD);
        if (ph == 0) { if constexpr ((EN & 1) != 0) {
            {
                LAS float* scr = (LAS float*)(ldsl + wave * 16640);
                for (int it = gw; it < I_L; it += NGW) convert_item(ap, ws, 0, it, scr, lane);
            }
            {
                const GAS f32x4* xs = (const GAS f32x4*)ap->in[0]; const GAS f32x4* cs = (const GAS f32x4*)ap->in[2]; GAS u32x4* xd = (GAS u32x4*)(ws + WS_X);
                const int nl = MLAT * DM / 8, nc = MCTX * DM / 8;
                const int cb0 = G > 144 ? 144 : 0, cnb = G - cb0;
                if (bx >= cb0) {
                    for (int i = (bx - cb0) * 512 + tid; i < nl; i += cnb * 512) { const f32x4 a = xs[2 * i], c = xs[2 * i + 1]; xd[i] = (u32x4){cvtpk(a.x, a.y), cvtpk(a.z, a.w), cvtpk(c.x, c.y), cvtpk(c.z, c.w)}; }
                    for (int i = (bx - cb0) * 512 + tid; i < nc; i += cnb * 512) { const f32x4 a = cs[2 * i], c = cs[2 * i + 1]; xd[nl + i] = (u32x4){cvtpk(a.x, a.y), cvtpk(a.z, a.w), cvtpk(c.x, c.y), cvtpk(c.z, c.w)}; }
                }
            }
            {
                for (int i = bx * 512 + tid; i < DEPTH * 1536 * 80; i += G * 512) {
                    const int l = i / (1536 * 80), r2 = i % (1536 * 80), row = r2 / 80, ch = r2 % 80;
                    const bool z = row < 768 ? (ch >= 48) : (ch < 48);
                    if (z) *(u32x4*)((bf16*)(ws + WS_WUP + l * SZ_WUP) + (size_t)row * 640 + ch * 8) = (u32x4){0u, 0u, 0u, 0u};
                }
            }
            __syncthreads();
            {
                LAS float* S = (LAS float*)ldsl;
                LAS float* red = (LAS float*)(ldsl + 36864);
                for (int i = tid; i < 9 * DM; i += 512) { const int r = i >> 10, k = i & 1023; const float v = r < 8 ? ap->in[1][r * DM + k] : ap->in[3][k]; S[i] = v / (1.0f + expf(-v)); }
                __syncthreads();
                for (int item = bx; item < DEPTH * 36; item += G) {
                    const int l = item / 36, n0 = (item % 36) * 256;
                    f32x4 acc[9];
#pragma unroll
                    for (int r = 0; r < 9; ++r) acc[r] = (f32x4){0.f, 0.f, 0.f, 0.f};
                    const GAS float* w = (const GAS float*)ap->in[4] + (size_t)l * DM * (NMOD * DM) + (size_t)(wave * 128) * (NMOD * DM) + n0 + 4 * lane;
#pragma unroll 16
                    for (int kk = 0; kk < 128; ++kk) {
                        const f32x4 wv = *(const GAS f32x4*)(w + (size_t)kk * (NMOD * DM));
#pragma unroll
                        for (int r = 0; r < 9; ++r) acc[r] += wv * S[r * DM + wave * 128 + kk];
                    }
#pragma unroll
                    for (int r = 0; r < 9; ++r) *(LAS f32x4*)(red + (wave * 9 + r) * 256 + 4 * lane) = acc[r];
                    __syncthreads();
                    for (int o = tid; o < 9 * 256; o += 512) {
                        const int r = o >> 8, cc = o & 255; float sm = ap->in[5][l * (NMOD * DM) + n0 + cc];
#pragma unroll
                        for (int k2 = 0; k2 < 8; ++k2) sm += red[(k2 * 9 + r) * 256 + cc];
                        MOD[(size_t)(l * 9 + r) * (NMOD * DM) + n0 + cc] = sm;
                    }
                    __syncthreads();
                }
            }
        } } else {
            const int l = (ph - 1) / 13, sp = (ph - 1) % 13;
            const bool last = (l == DEPTH - 1);
            const float* modl = MOD + (size_t)l * 9 * (NMOD * DM);
            if ((EN & 2) && (sp == 0 || sp == 3 || sp == 10)) {
                const int which = sp == 0 ? 0 : (sp == 3 ? 1 : 2);
                const int kshift = which == 0 ? 0 : (which == 1 ? 3 : 6);
                const int nrows = (sp == 10 && last) ? MLAT : MTOT;
                GAS bf16* X = (GAS bf16*)(ws + WS_X); GAS bf16* Hb = (GAS bf16*)(ws + WS_H);
                const GAS float* gn = (const GAS float*)ap->in[6] + (size_t)(l * 3 + which) * DM;
                float gg[16], am[16], bm[16];
#pragma unroll
                for (int j = 0; j < 2; ++j)
#pragma unroll
                    for (int e = 0; e < 8; ++e) { gg[8 * j + e] = gn[512 * j + 8 * lane + e]; am[8 * j + e] = 0.f; bm[8 * j + e] = 0.f; }
                const int rpc = nrows > MLAT ? (MCTX + NGW - 1) / NGW : 0, rpl = (MLAT + NGW - 1) / NGW, nk = rpc + rpl;
#define ROWOF(k) ((k) < rpc ? ((gw * rpc + (k)) < MCTX ? MLAT + gw * rpc + (k) : -1) : ((gw * rpl + (k) - rpc) < MLAT ? gw * rpl + (k) - rpc : -1))
#define XLOAD(dst, row) do { const GAS u32x4* xr_ = (const GAS u32x4*)(X + (size_t)(row) * DM) + lane; dst[0] = xr_[0]; dst[1] = xr_[64]; } while (0)
                u32x4 va[2], vb[2], vc[2];
                va[0] = va[1] = vb[0] = vb[1] = vc[0] = vc[1] = (u32x4){0u, 0u, 0u, 0u};
                { const int ra = ROWOF(0); if (nk > 0 && ra >= 0) XLOAD(va, ra); }
                { const int rb = ROWOF(1); if (nk > 1 && rb >= 0) XLOAD(vb, rb); }
                int cur_mr = -1;
                const bool haspart = (sp != 0 || l > 0) && (256 % G) == 0;
                u32x4 pq[SPLITS][2];
                const int r_first = ROWOF(0); const bool pf = haspart && nk > 0 && r_first >= MLAT;
#pragma unroll
                for (int sq = 0; sq < SPLITS; ++sq) { pq[sq][0] = (u32x4){0u, 0u, 0u, 0u}; pq[sq][1] = pq[sq][0]; }
                if (pf) {
#pragma unroll
                    for (int sq = 0; sq < SPLITS; ++sq) { const GAS bf16* pr = (const GAS bf16*)(ws + WS_PART) + ((size_t)sq * MCTX + (r_first - MLAT)) * DM + 8 * lane;
                        pq[sq][0] = *(const GAS u32x4*)pr; pq[sq][1] = *(const GAS u32x4*)(pr + 512); } }
                for (int k = 0; k < nk; ++k) {
                    const int r = ROWOF(k);
                    { const int rc = ROWOF(k + 2); if (k + 2 < nk && rc >= 0) XLOAD(vc, rc); }
                    if (r >= 0) {
                    const int mr = r < MLAT ? (r >> 11) : 8;
                    if (mr != cur_mr) { cur_mr = mr; const GAS float* sh = (const GAS float*)modl + (size_t)mr * (NMOD * DM) + kshift * DM; const GAS float* sc = sh + DM;
#pragma unroll
                        for (int j = 0; j < 2; ++j)
#pragma unroll
                            for (int e = 0; e < 8; ++e) { am[8 * j + e] = gg[8 * j + e] * (sc[512 * j + 8 * lane + e] + 1.0f); bm[8 * j + e] = sh[512 * j + 8 * lane + e]; } }
                    float v[16];
#pragma unroll
                    for (int j = 0; j < 2; ++j) { const u32x4 u = va[j];
                        v[8 * j + 0] = __builtin_bit_cast(float, u.x << 16); v[8 * j + 1] = __builtin_bit_cast(float, u.x & 0xffff0000u); v[8 * j + 2] = __builtin_bit_cast(float, u.y << 16); v[8 * j + 3] = __builtin_bit_cast(float, u.y & 0xffff0000u);
                        v[8 * j + 4] = __builtin_bit_cast(float, u.z << 16); v[8 * j + 5] = __builtin_bit_cast(float, u.z & 0xffff0000u); v[8 * j + 6] = __builtin_bit_cast(float, u.w << 16); v[8 * j + 7] = __builtin_bit_cast(float, u.w & 0xffff0000u); }
                    if (haspart && r >= MLAT) {
#pragma unroll
                        for (int sq = 0; sq < SPLITS; ++sq) { const GAS bf16* pr = (const GAS bf16*)(ws + WS_PART) + ((size_t)sq * MCTX + (r - MLAT)) * DM + 8 * lane;
#pragma unroll
                            for (int j = 0; j < 2; ++j) { const u32x4 a = (pf && k == 0) ? pq[sq][j] : *(const GAS u32x4*)(pr + 512 * j);
                                v[8 * j + 0] += __builtin_bit_cast(float, a.x << 16); v[8 * j + 1] += __builtin_bit_cast(float, a.x & 0xffff0000u); v[8 * j + 2] += __builtin_bit_cast(float, a.y << 16); v[8 * j + 3] += __builtin_bit_cast(float, a.y & 0xffff0000u);
                                v[8 * j + 4] += __builtin_bit_cast(float, a.z << 16); v[8 * j + 5] += __builtin_bit_cast(float, a.z & 0xffff0000u); v[8 * j + 6] += __builtin_bit_cast(float, a.w << 16); v[8 * j + 7] += __builtin_bit_cast(float, a.w & 0xffff0000u); } }
                        GAS u32x4* xw = (GAS u32x4*)(X + (size_t)r * DM) + lane;
#pragma unroll
                        for (int j = 0; j < 2; ++j) { const u32x4 o = (u32x4){cvtpk(v[8 * j], v[8 * j + 1]), cvtpk(v[8 * j + 2], v[8 * j + 3]), cvtpk(v[8 * j + 4], v[8 * j + 5]), cvtpk(v[8 * j + 6], v[8 * j + 7])}; xw[64 * j] = o;
                            v[8 * j + 0] = __builtin_bit_cast(float, o.x << 16); v[8 * j + 1] = __builtin_bit_cast(float, o.x & 0xffff0000u); v[8 * j + 2] = __builtin_bit_cast(float, o.y << 16); v[8 * j + 3] = __builtin_bit_cast(float, o.y & 0xffff0000u);
                            v[8 * j + 4] = __builtin_bit_cast(float, o.z << 16); v[8 * j + 5] = __builtin_bit_cast(float, o.z & 0xffff0000u); v[8 * j + 6] = __builtin_bit_cast(float, o.w << 16); v[8 * j + 7] = __builtin_bit_cast(float, o.w & 0xffff0000u); }
                    }
                    float ss = 0.f;
#pragma unroll
                    for (int e = 0; e < 16; ++e) ss += v[e] * v[e];
                    const float rstd = rsqrtf(wave_sum(ss, lane) * (1.0f / DM) + EPS);
                    GAS u32x4* o8 = (GAS u32x4*)(Hb + (size_t)r * DM) + lane;
#pragma unroll
                    for (int j = 0; j < 2; ++j) { float y[8];
#pragma unroll
                        for (int e = 0; e < 8; ++e) y[e] = v[8 * j + e] * rstd * am[8 * j + e] + bm[8 * j + e];
                        o8[64 * j] = (u32x4){cvtpk(y[0], y[1]), cvtpk(y[2], y[3]), cvtpk(y[4], y[5]), cvtpk(y[6], y[7])}; }
                    }
                    va[0] = vb[0]; va[1] = vb[1]; vb[0] = vc[0]; vb[1] = vc[1];
                }
#undef ROWOF
#undef XLOAD
            } else if ((EN & 32) && sp == 5) {
                const GAS bf16* P = (const GAS bf16*)(ws + WS_P);
                GAS bf16* CQKV = (GAS bf16*)(ws + WS_CQKV); GAS bf16* QA = (GAS bf16*)(ws + WS_QA); GAS bf16* KA = (GAS bf16*)(ws + WS_KA);
                GAS bf16* VA = (GAS bf16*)(ws + WS_VA); GAS bf16* KM = (GAS bf16*)(ws + WS_KM); GAS bf16* YC = (GAS bf16*)(ws + WS_YC);
                const int hh = lane >> 3, dim0 = (lane & 7) * 8;
                float g8[8], inv8[8], ik8[8], gkr8[8], gc0[8], gc1[8], cw0[4], cw1[4], cw2[4], cb4[4];
                { const float* gsrc = (hh < 6 ? ap->in[12] : ap->in[13]) + l * 64 + dim0;
                  const float* gcq = ap->in[16] + l * 384; const float* gckv = ap->in[17] + l * 256; const float* gkr = ap->in[23] + l * 32 + (lane & 3) * 8;
                  const float* cw = ap->in[14] + l * 3 * 256 + 4 * lane; const float* cb = ap->in[15] + l * 256 + 4 * lane;
#pragma unroll
                  for (int e = 0; e < 8; ++e) { g8[e] = gsrc[e] * (hh < 6 ? QSCALE_A : 1.0f); inv8[e] = rope_inv64((lane & 1) * 8 + e); ik8[e] = rope_inv32(e); gkr8[e] = gkr[e];
                      gc0[e] = lane < 48 ? gcq[8 * lane + e] : gckv[8 * (lane - 48) + e]; gc1[e] = gckv[128 + 8 * (lane & 15) + e]; }
#pragma unroll
                  for (int i = 0; i < 4; ++i) { cw0[i] = cw[i]; cw1[i] = cw[256 + i]; cw2[i] = cw[512 + i]; cb4[i] = cb[i]; } }
#define UNPK8(u, f) do { f[0] = __builtin_bit_cast(float, (u).x << 16); f[1] = __builtin_bit_cast(float, (u).x & 0xffff0000u); f[2] = __builtin_bit_cast(float, (u).y << 16); f[3] = __builtin_bit_cast(float, (u).y & 0xffff0000u); \
                          f[4] = __builtin_bit_cast(float, (u).z << 16); f[5] = __builtin_bit_cast(float, (u).z & 0xffff0000u); f[6] = __builtin_bit_cast(float, (u).w << 16); f[7] = __builtin_bit_cast(float, (u).w & 0xffff0000u); } while (0)
#define PK8(f) ((u32x4){cvtpk(f[0], f[1]), cvtpk(f[2], f[3]), cvtpk(f[4], f[5]), cvtpk(f[6], f[7])})
                for (int r = gw; r < MTOT; r += NGW) {
                    const bool lat = r < MLAT; int b, s;
                    if (lat) { b = r >> 11; s = r & 2047; } else { b = (r - MLAT) >> 8; s = (r - MLAT) & 255; }
                    const int pos = lat ? CTXL + s : s, smax = lat ? SEQ - 1 : CTXL - 1;
                    const float prow = (float)(s >> 6), pcol = (float)(s & 63);
                    const GAS bf16* p = P + (size_t)r * INP;
                    const u32x4 a8 = *(const GAS u32x4*)(p + 8 * lane);
                    const u32x4 v8 = *(const GAS u32x4*)(p + PC_V + 8 * (lane & 15));
                    const u32x4 c0 = *(const GAS u32x4*)(p + PC_CQ + 8 * lane);
                    const u32x4 c1 = *(const GAS u32x4*)(p + PC_CQ + 512 + 8 * (lane & 15));
                    const u32x4 k8 = *(const GAS u32x4*)(p + PC_KR + 8 * (lane & 3));
                    const u32x2 xi = *(const GAS u32x2*)(p + PC_X + 4 * lane), cg = *(const GAS u32x2*)(p + PC_CG + 4 * lane), bg = *(const GAS u32x2*)(p + PC_BG + 4 * lane);
                    u32x2 xm = (u32x2){0u, 0u}, cm = xm, xp = xm, cp = xm;
                    if (s > 0) { xm = *(const GAS u32x2*)(p - INP + PC_X + 4 * lane); cm = *(const GAS u32x2*)(p - INP + PC_CG + 4 * lane); }
                    if (s < smax) { xp = *(const GAS u32x2*)(p + INP + PC_X + 4 * lane); cp = *(const GAS u32x2*)(p + INP + PC_CG + 4 * lane); }
                    { float v[8]; UNPK8(a8, v); float ss = 0.f;
#pragma unroll
                      for (int e = 0; e < 8; ++e) ss += v[e] * v[e];
                      ss += dpp_x1(ss); ss += dpp_x2(ss); ss += dpp_hm(ss);
                      const float rs = rsqrtf(ss * (1.0f / 64.0f) + EPS);
#pragma unroll
                      for (int e = 0; e < 8; ++e) v[e] = v[e] * rs * g8[e];
                      if (lat) { const float posv = (lane & 7) < 4 ? prow : pcol;
#pragma unroll
                          for (int e = 0; e < 8; ++e) { const float ang = posv * inv8[e], c = __cosf(ang), sn = __sinf(ang); const float yp = dpp_x2(v[e]);
                              v[e] = (lane & 2) ? v[e] * c + yp * sn : v[e] * c - yp * sn; } }
                      GAS bf16* dst = hh < 6 ? QA + ((size_t)(b * 6 + hh) * LKV + pos) * 64 + dim0 : KA + ((size_t)(b * 2 + hh - 6) * LKV + pos) * 64 + dim0;
                      *(GAS u32x4*)dst = PK8(v); }
                    if (lane < 16) *(GAS u32x4*)(VA + ((size_t)(b * 2 + (lane >> 3)) * LKV + pos) * 64 + (lane & 7) * 8) = v8;
                    { float w[8]; UNPK8(k8, w); float ss = 0.f;
#pragma unroll
                      for (int e = 0; e < 8; ++e) ss += w[e] * w[e];
                      ss += dpp_x1(ss); ss += dpp_x2(ss);
                      const float rs = rsqrtf(ss * (1.0f / 32.0f) + EPS);
#pragma unroll
                      for (int e = 0; e < 8; ++e) w[e] = w[e] * rs * gkr8[e];
                      if (lat) { const float posv = (lane & 3) < 2 ? prow : pcol;
#pragma unroll
                          for (int e = 0; e < 8; ++e) { const float ang = posv * ik8[e], c = __cosf(ang), sn = __sinf(ang); const float zp = dpp_x1(w[e]);
                              w[e] = (lane & 1) ? w[e] * c + zp * sn : w[e] * c - zp * sn; } }
                      if (lane < 24) *(GAS u32x4*)(KM + ((size_t)(b * 6 + (lane >> 2)) * LKV + pos) * 96 + 64 + (lane & 3) * 8) = PK8(w); }
                    { float q0[8], q1[8]; UNPK8(c0, q0); UNPK8(c1, q1); float s0 = 0.f, s1 = 0.f;
#pragma unroll
                      for (int e = 0; e < 8; ++e) { s0 += q0[e] * q0[e]; s1 += q1[e] * q1[e]; }
                      const float sq = wave_sum(lane < 48 ? s0 : 0.f, lane), sk = wave_sum((lane >= 48 ? s0 : 0.f) + (lane < 16 ? s1 : 0.f), lane);
                      const float rq = rsqrtf(sq * (1.0f / 384.0f) + EPS), rk = rsqrtf(sk * (1.0f / 256.0f) + EPS), r0 = lane < 48 ? rq : rk;
#pragma unroll
                      for (int e = 0; e < 8; ++e) { q0[e] = q0[e] * r0 * gc0[e]; q1[e] = q1[e] * rk * gc1[e]; }
                      *(GAS u32x4*)(CQKV + (size_t)r * 640 + 8 * lane) = PK8(q0);
                      if (lane < 16) *(GAS u32x4*)(CQKV + (size_t)r * 640 + 512 + 8 * lane) = PK8(q1); }
                    { float y[4];
#pragma unroll
                      for (int i = 0; i < 4; ++i) {
                          const unsigned xw = i < 2 ? xi.x : xi.y, cgw = i < 2 ? cg.x : cg.y, bgw = i < 2 ? bg.x : bg.y, xmw = i < 2 ? xm.x : xm.y, cmw = i < 2 ? cm.x : cm.y, xpw = i < 2 ? xp.x : xp.y, cpw = i < 2 ? cp.x : cp.y;
#define HALF16(wd) __builtin_bit_cast(float, (i & 1) ? ((wd) & 0xffff0000u) : ((wd) << 16))
                          const float u1 = HALF16(cgw) * HALF16(xw), u0 = HALF16(cmw) * HALF16(xmw), u2 = HALF16(cpw) * HALF16(xpw);
                          y[i] = HALF16(bgw) * (u0 * cw0[i] + u1 * cw1[i] + u2 * cw2[i] + cb4[i]);
#undef HALF16
                      }
                      *(GAS u32x2*)(YC + (size_t)r * DM + 384 + 4 * lane) = (u32x2){cvtpk(y[0], y[1]), cvtpk(y[2], y[3])}; }
                }
            } else if ((EN & 128) && sp == 7) {
                const GAS bf16* QKVR = (const GAS bf16*)(ws + WS_QKVR); GAS bf16* QM = (GAS bf16*)(ws + WS_QM); GAS bf16* KM = (GAS bf16*)(ws + WS_KM); GAS bf16* VM = (GAS bf16*)(ws + WS_VM);
                const int sub = lane & 15;
                float gs0[8], gs1[8], gs2[8], ik8[8];
                { const float* gqn = ap->in[20] + l * 64; const float* gkn = ap->in[21] + l * 64; const float* gqr = ap->in[22] + l * 32;
#pragma unroll
                  for (int e = 0; e < 8; ++e) {
                      const float gq = sub < 8 ? gqn[8 * sub + e] * QSCALE_M : (sub < 12 ? gqr[8 * (sub - 8) + e] * QSCALE_M : 0.f);
                      const float gk = sub < 8 ? gkn[8 * sub + e] : 0.f;
                      gs0[e] = gq; gs1[e] = lane < 32 ? gq : gk; gs2[e] = gk; ik8[e] = rope_inv32(e); } }
                const float invn_q = sub < 8 ? (1.0f / 64.0f) : (1.0f / 32.0f);
                for (int r = gw; r < MTOT; r += NGW) {
                    const bool lat = r < MLAT; int b, s;
                    if (lat) { b = r >> 11; s = r & 2047; } else { b = (r - MLAT) >> 8; s = (r - MLAT) & 255; }
                    const int pos = lat ? CTXL + s : s;
                    const float posv = sub < 10 ? (float)(s >> 6) : (float)(s & 63);
                    const GAS bf16* q = QKVR + (size_t)r * 1536 + 8 * lane;
                    const u32x4 d0 = *(const GAS u32x4*)q, d1 = *(const GAS u32x4*)(q + 512), d2 = *(const GAS u32x4*)(q + 1024);
#pragma unroll
                    for (int i = 0; i < 3; ++i) {
                        const u32x4 d = i == 0 ? d0 : (i == 1 ? d1 : d2);
                        const bool isq = i == 0 || (i == 1 && lane < 32);
                        const int head = i == 0 ? (lane >> 4) : (i == 1 ? (lane < 32 ? 4 + (lane >> 4) : (lane >> 4) - 2) : 2 + (lane >> 4));
                        float v[8]; UNPK8(d, v);
                        const bool pad = isq && sub >= 12;
                        float ss = 0.f;
#pragma unroll
                        for (int e = 0; e < 8; ++e) { v[e] = pad ? 0.f : v[e]; ss += v[e] * v[e]; }
                        ss += dpp_x1(ss); ss += dpp_x2(ss); ss += dpp_hm(ss);
                        const float rs = rsqrtf(ss * (isq ? invn_q : (1.0f / 64.0f)) + EPS);
#pragma unroll
                        for (int e = 0; e < 8; ++e) v[e] = v[e] * rs * (i == 0 ? gs0[e] : (i == 1 ? gs1[e] : gs2[e]));
                        if (i < 2 && lat) {
                            const bool rp = isq && sub >= 8 && sub < 12;
#pragma unroll
                            for (int e = 0; e < 8; ++e) { const float ang = posv * ik8[e], c = __cosf(ang), sn = __sinf(ang); const float yp = dpp_x1(v[e]);
                                const float rot = (sub & 1) ? v[e] * c + yp * sn : v[e] * c - yp * sn; v[e] = rp ? rot : v[e]; }
                        }
                        const size_t tok = (size_t)(b * 6 + head) * LKV + pos;
                        if (isq) { if (!pad) *(GAS u32x4*)(QM + tok * 96 + (sub < 8 ? 8 * sub : 64 + 8 * (sub - 8))) = PK8(v); }
                        else if (sub < 8) *(GAS u32x4*)(KM + tok * 96 + 8 * sub) = PK8(v);
                        else *(GAS u32x4*)(VM + tok * 64 + 8 * (sub - 8)) = d;
                    }
                }
#undef UNPK8
#undef PK8
            } else if ((EN & 256) && sp == 8) {
                const int vcu = (G % 8 == 0) ? (bx % 8) * (G / 8) + bx / 8 : bx;
                const int nh = (768 - vcu + G - 1) / G;
                for (int k = 0; k < nh + 1; ++k) {
                    int kind, bh, j;
                    if (k < nh) { const int u = vcu + k * G; kind = u < 384 ? 1 : 0; const int rem = u % 384; bh = rem >> 3; j = 1 + (rem & 7); }
                    else { const int u2 = G - 1 - vcu; if (last || u2 >= 96 || u2 < 0) break; kind = u2 < 48 ? 1 : 0; bh = u2 % 48; j = 0; }
                    const int b = bh / 6, h = bh % 6, nk = j == 0 ? CTXL : LKV;
                    if (kind) attn_unit<96>(ldsl, (const GAS bf16*)(ws + WS_QM) + (size_t)bh * LKV * 96, (const GAS bf16*)(ws + WS_KM) + (size_t)bh * LKV * 96, (const GAS bf16*)(ws + WS_VM) + (size_t)bh * LKV * 64,
                                            (GAS bf16*)(ws + WS_YC) + 640 + h * 64, b, j, nk, tid, lane, wave);
                    else attn_unit<64>(ldsl, (const GAS bf16*)(ws + WS_QA) + (size_t)bh * LKV * 64, (const GAS bf16*)(ws + WS_KA) + (size_t)(b * 2 + h / 3) * LKV * 64, (const GAS bf16*)(ws + WS_VA) + (size_t)(b * 2 + h / 3) * LKV * 64,
                                       (GAS bf16*)(ws + WS_YC) + h * 64, b, j, nk, tid, lane, wave);
                }
            } else if ((EN & 4) && (sp == 1 || sp == 11)) {
                const int lj = l * 2 + (sp == 11 ? 1 : 0); const int M = (sp == 11 && last) ? MLAT : MTOT;
                pg8::Gemm g{(const bf16*)(ws + WS_H), (const bf16*)(ws + WS_WGU + lj * SZ_WGU), M, NGU, DM}; pg8::StaticOrder S; S.init(M, NGU, G, bx, DM);
                pg8::EpiSwiGLU E{(bf16*)(ws + WS_GU)};
                pg8::gemm_phase<pg8::EpiSwiGLU, pg8::StaticOrder, true, true>(ldsl, g, S, E, tid);
                if (l + 1 < DEPTH) {
                    const int nfull = S.nwg / G, nbusy = S.nwg - nfull * G;
                    if (bx >= nbusy && nbusy > 0) {
                        __syncthreads();
                        int lane2 = __lane_id(); asm volatile("" : "+v"(lane2));
                        LAS float* scr = (LAS float*)((LAS unsigned char*)lds + wave * 16640);
                        const int half = (I_L + 1) / 2, first = sp == 1 ? 0 : half, lastit = sp == 1 ? half : I_L, nw = (G - nbusy) * 8;
                        for (int it = first + (bx - nbusy) * 8 + wave; it < lastit; it += nw) convert_item(ap, ws, l + 1, it, scr, lane2);
                    }
                }
            } else if ((EN & 8) && (sp == 2 || sp == 12 || sp == 9)) {
                const int lj = l * 2 + (sp == 12 ? 1 : 0); const int M = (sp != 2 && last) ? MLAT : MTOT;
                bf16* Xp = (bf16*)(ws + WS_X);
                pg8::Gemm g{uptr((const bf16*)(ws + (sp == 9 ? WS_YC : WS_GU))), uptr((const bf16*)(sp == 9 ? ws + WS_WOUT + l * SZ_WOUT : ws + WS_WD + lj * SZ_WD)), M, DM, __builtin_amdgcn_readfirstlane(sp == 9 ? DM : DFF)};
                const int Kd = __builtin_amdgcn_readfirstlane(sp == 9 ? DM : DFF);
                pg8::LatCtxOrder S; S.init(M, G, bx, Kd, SPLITS);
                pg8::EpiResid E{uptr(Xp), uptr(Xp), uptr((sp == 12 && last) ? ap->out : (float*)nullptr), uptr(modl), __builtin_amdgcn_readfirstlane(sp == 2 ? 2 : (sp == 9 ? 5 : 8)), __builtin_bit_cast(float, __builtin_amdgcn_readfirstlane(sp == 9 ? 0x3f800000 : 0x3f000000))};
                pg8::gemm_phase<pg8::EpiResid, pg8::LatCtxOrder, true, true>(ldsl, g, S, E, tid);
            } else if ((EN & 16) && (sp == 4 || sp == 6)) {
                const bf16* A; const bf16* Bt; bf16* O; int N, K;
                if (sp == 4) { A = (const bf16*)(ws + WS_H); Bt = (const bf16*)(ws + WS_WIN + l * SZ_WIN); O = (bf16*)(ws + WS_P); N = INP; K = DM; }
                else { A = (const bf16*)(ws + WS_CQKV); Bt = (const bf16*)(ws + WS_WUP + l * SZ_WUP); O = (bf16*)(ws + WS_QKVR); N = 1536; K = 640; }
                pg8::Gemm g{uptr(A), uptr(Bt), MTOT, __builtin_amdgcn_readfirstlane(N), __builtin_amdgcn_readfirstlane(K)}; pg8::BdOrder S; S.init(MTOT, N, G, bx, K, sp == 6);
                pg8::EpiBf16<0> E{uptr(O), __builtin_amdgcn_readfirstlane(N), nullptr, 0, 0, 1.f};
                pg8::gemm_phase<pg8::EpiBf16<0>, pg8::BdOrder, true, true>(ldsl, g, S, E, tid);
            }
        }
        if (ph + 1 < ph_hi) { if (ph_hi < 0) grid.sync(); else xcd_barrier(xbar); }
#if DBL
        { const int bit = ph == 0 ? 13 : (ph - 1) % 13;
          if (!redo && ((DBL >> bit) & 1)) { redo = true; --ph; } else redo = false; }
#endif
    }
}

extern "C" void kernel_launch(void* const* d_in, const int* in_sizes, int n_in, void* d_out, int out_size, void* d_ws, size_t ws_size, hipStream_t stream) {
    static int grid_blocks = 0;
    if (grid_blocks == 0) {
        if (n_in != 24 || out_size != MLAT * DM || ws_size < WS_END) { fprintf(stderr, "kernel_launch: unexpected problem (n_in %d out %d ws %zu need %zu)\n", n_in, out_size, ws_size, (size_t)WS_END); grid_blocks = -1; return; }
        int dev = 0, cus = 0, per_cu = 0;
        (void)hipGetDevice(&dev);
        (void)hipDeviceGetAttribute(&cus, hipDeviceAttributeMultiprocessorCount, dev);
        (void)hipFuncSetAttribute((const void*)fwd_mega, hipFuncAttributeMaxDynamicSharedMemorySize, LDS_BYTES);
        (void)hipOccupancyMaxActiveBlocksPerMultiprocessor(&per_cu, (const void*)fwd_mega, 512, LDS_BYTES);
        if (per_cu < 1) per_cu = 1;
        grid_blocks = cus * per_cu;
        fprintf(stderr, "kernel_launch: grid %d (cus %d x %d), ws %zu need %zu\n", grid_blocks, cus, per_cu, ws_size, (size_t)WS_END);
    }
    if (grid_blocks < 0) return;
    if (hipMemsetAsync((char*)d_ws + WS_CTL, 0, CTL_BYTES, stream) != hipSuccess) { fprintf(stderr, "kernel_launch: memset of the barrier words failed\n"); return; }
    Args a{};
    for (int i = 0; i < 24; ++i) a.in[i] = (const float*)d_in[i];
    a.out = (float*)d_out; a.ws = (unsigned char*)d_ws;
#if MK_MULTI
    for (int ph = 0; ph < NPHASE; ++ph) {
        a.ph_lo = ph; a.ph_hi = ph + 1;
        void* kargs[] = {&a};
        hipError_t e = hipLaunchCooperativeKernel((const void*)fwd_mega, dim3(grid_blocks), dim3(512), kargs, LDS_BYTES, stream);
        if (e != hipSuccess) { fprintf(stderr, "kernel_launch: cooperative launch failed: %s\n", hipGetErrorString(e)); break; }
    }
#else
    a.ph_lo = 0; a.ph_hi = NPHASE;
    void* kargs[] = {&a};
    hipError_t e = hipLaunchCooperativeKernel((const void*)fwd_mega, dim3(grid_blocks), dim3(512), kargs, LDS_BYTES, stream);
    if (e != hipSuccess) fprintf(stderr, "kernel_launch: cooperative launch failed: %s\n", hipGetErrorString(e));
#endif
}
```
